# Optimizing an MI355X kernel written in HIP

```python
import jax
import jax.numpy as jnp
from jax import lax
import numpy as np

D_MODEL = 1024
BATCH = 4
SEQ = 4096
DEPTH = 4

GRID_W = 64
CTX_LEN = 256
N_MOD = 9
ATTN_HEAD_DIM = 64
ATTN_WIDTH = D_MODEL // 2
ATTN_HEADS = ATTN_WIDTH // ATTN_HEAD_DIM
RWKV_HEAD_DIM = 64
RWKV_WIDTH = D_MODEL - ATTN_WIDTH
RWKV_HEADS = RWKV_WIDTH // RWKV_HEAD_DIM
NA_ROWS = 8
NA_COLS = 16
DECAY_LORA = 64
ICLR_LORA = 64
GATE_LORA = 128
D_FF = ((8 * D_MODEL // 3 + 127) // 128) * 128
RWKV_IN = 3 * RWKV_WIDTH + DECAY_LORA + ICLR_LORA + GATE_LORA
D_IN = 3 * ATTN_WIDTH + RWKV_IN
RWKV_SPLITS = (RWKV_WIDTH, 2 * RWKV_WIDTH, 3 * RWKV_WIDTH,
               3 * RWKV_WIDTH + DECAY_LORA, 3 * RWKV_WIDTH + DECAY_LORA + ICLR_LORA)
ATTN_SCALE = ATTN_HEAD_DIM ** -0.5
RMS_EPS = 1e-6
LNX_EPS = 64e-5
L2_EPS = 1e-24
NEG_INF = -1e30

kernel_name = 'hybrid_na_rwkv7_macaron_dit'


def rms_norm(x, gain):
    xf = x.astype(jnp.float32)
    y = xf * lax.rsqrt(jnp.mean(xf * xf, axis=-1, keepdims=True) + RMS_EPS)
    return (y * gain.astype(jnp.float32)).astype(x.dtype)


def modulate(x, shift, scale):
    return x * (1 + scale) + shift


def swiglu(x, w_up, w_down):
    gate, up = jnp.split(x @ w_up, 2, axis=-1)
    return (jax.nn.silu(gate) * up) @ w_down


def attn_heads(p, q_gain, k_gain):
    b, n, _ = p.shape
    q, k, v = jnp.split(p, 3, axis=-1)
    shape = (b, n, ATTN_HEADS, ATTN_HEAD_DIM)
    q = rms_norm(q.reshape(shape), q_gain) * ATTN_SCALE
    k = rms_norm(k.reshape(shape), k_gain)
    return q, k, v.reshape(shape)


def neighbourhood_attention(q, k, v, k_ctx, v_ctx, rel_bias):
    b, t, h, d = q.shape
    rows = t // GRID_W
    kr = min(NA_ROWS, rows)
    qg = q.reshape(b, rows, GRID_W, h, d)
    kg = k.reshape(b, rows, GRID_W, h, d)
    vg = v.reshape(b, rows, GRID_W, h, d)
    cols = jnp.arange(GRID_W)
    col_start = jnp.clip(cols - NA_COLS // 2, 0, GRID_W - NA_COLS)
    in_window = (cols[None, :] >= col_start[:, None]) & (cols[None, :] < col_start[:, None] + NA_COLS)
    dc = jnp.clip(cols[None, :] - cols[:, None], -(NA_COLS - 1), NA_COLS - 1) + (NA_COLS - 1)

    def row_block(i):
        start = jnp.clip(i - kr // 2, 0, rows - kr)
        q_i = lax.dynamic_index_in_dim(qg, i, axis=1, keepdims=False)
        k_i = lax.dynamic_slice_in_dim(kg, start, kr, axis=1)
        v_i = lax.dynamic_slice_in_dim(vg, start, kr, axis=1)
        dr = start + jnp.arange(kr) - i + (NA_ROWS - 1)
        bias = rel_bias[:, dr[None, :, None], dc[:, None, :]].astype(jnp.float32)
        bias = jnp.where(in_window[None, :, None, :], bias, NEG_INF)
        s_loc = jnp.einsum('bqhd,brwhd->bhqrw', q_i, k_i).astype(jnp.float32) + bias[None]
        s_loc = s_loc.reshape(b, h, GRID_W, kr * GRID_W)
        s_ctx = jnp.einsum('bqhd,bchd->bhqc', q_i, k_ctx).astype(jnp.float32)
        p = jax.nn.softmax(jnp.concatenate([s_loc, s_ctx], axis=-1), axis=-1).astype(v.dtype)
        p_loc = p[..., :kr * GRID_W].reshape(b, h, GRID_W, kr, GRID_W)
        p_ctx = p[..., kr * GRID_W:]
        return (jnp.einsum('bhqrw,brwhd->bqhd', p_loc, v_i)
                + jnp.einsum('bhqc,bchd->bqhd', p_ctx, v_ctx))

    out = lax.map(row_block, jnp.arange(rows))
    return jnp.moveaxis(out, 0, 1).reshape(b, t, h * d)


def context_attention(q, k, v):
    b, n, h, d = q.shape
    s = jnp.einsum('bqhd,bkhd->bhqk', q, k).astype(jnp.float32)
    p = jax.nn.softmax(s, axis=-1).astype(v.dtype)
    return jnp.einsum('bhqk,bkhd->bqhd', p, v).reshape(b, n, h * d)


def centred_shift(p):
    padded = jnp.pad(p, ((0, 0), (1, 1), (0, 0)))
    return 0.5 * (padded[:, :-2] + padded[:, 2:])


def rwkv_prepare(p, shift_mu, decay_w0, decay_w2, iclr_a0, iclr_a2, gate_g2, key_k, key_a):
    b, n, _ = p.shape
    p = p + shift_mu * (centred_shift(p) - p)
    r, k, v, dw, da, dg = jnp.split(p, RWKV_SPLITS, axis=-1)
    heads = lambda t: t.astype(jnp.float32).reshape(b, n, RWKV_HEADS, RWKV_HEAD_DIM)
    g = jax.nn.sigmoid(dg) @ gate_g2
    kk = heads(k * key_k)
    kk = kk * lax.rsqrt(jnp.maximum(jnp.sum(kk * kk, axis=-1, keepdims=True), L2_EPS))
    per_dir = []
    for d in range(2):
        w_log = -jax.nn.softplus(-(decay_w0[d] + jnp.tanh(dw) @ decay_w2[d])) - 0.5
        a = jax.nn.sigmoid(iclr_a0[d] + da @ iclr_a2[d])
        k_d = k * (1 + (a - 1) * key_a)
        decay = jnp.exp(-jnp.exp(w_log.astype(jnp.float32)))
        per_dir.append((heads(decay), heads(k_d), heads(a)))
    return heads(r), heads(v), kk, g, per_dir


def rwkv_scan(state0, r, decay, k, v, kk, a, reverse):
    emit = r is not None

    def step(S, inp):
        r_t, w_t, k_t, v_t, kk_t, a_t = inp
        removal = jnp.einsum('bhvk,bhk->bhv', S, kk_t)
        S = (S * w_t[:, :, None, :]
             - removal[..., None] * (kk_t * a_t)[:, :, None, :]
             + v_t[..., None] * k_t[:, :, None, :])
        out = jnp.einsum('bhvk,bhk->bhv', S, r_t) if emit else None
        return S, out

    xs = jax.tree_util.tree_map(lambda t: jnp.moveaxis(t, 1, 0), (r, decay, k, v, kk, a))
    S, out = lax.scan(step, state0, xs, reverse=reverse)
    return S, (jnp.moveaxis(out, 0, 1) if emit else None)


def rwkv_readout(o_fwd, o_bwd, r, k_fwd, k_bwd, v, g, bonus_u, lnx_gain, lnx_bias):
    b, n, h, d = o_fwd.shape
    o = o_fwd + o_bwd
    mean = jnp.mean(o, axis=-1, keepdims=True)
    var = jnp.mean(jnp.square(o - mean), axis=-1, keepdims=True)
    o = ((o - mean) * lax.rsqrt(var + LNX_EPS)).reshape(b, n, h * d) * lnx_gain + lnx_bias
    bonus = jnp.sum(r * (k_fwd + k_bwd) * bonus_u, axis=-1, keepdims=True) * v
    return (o + bonus.reshape(b, n, h * d)) * g


def token_mixing(nx, ns, w_in, q_gain, k_gain, na_bias, shift_mu, decay_w0, decay_w2,
                 iclr_a0, iclr_a2, gate_g2, key_k, key_a, bonus_u, lnx_gain, lnx_bias,
                 w_out, emit_ctx):
    px = nx @ w_in
    ps = ns @ w_in
    q_x, k_x, v_x = attn_heads(px[..., :3 * ATTN_WIDTH], q_gain, k_gain)
    q_s, k_s, v_s = attn_heads(ps[..., :3 * ATTN_WIDTH], q_gain, k_gain)
    attn_x = neighbourhood_attention(q_x, k_x, v_x, k_s, v_s, na_bias)
    rwkv_args = (shift_mu, decay_w0, decay_w2, iclr_a0, iclr_a2, gate_g2, key_k, key_a)
    r_x, vr_x, kk_x, g_x, dirs_x = rwkv_prepare(px[..., 3 * ATTN_WIDTH:], *rwkv_args)
    r_s, vr_s, kk_s, g_s, dirs_s = rwkv_prepare(ps[..., 3 * ATTN_WIDTH:], *rwkv_args)
    state0 = jnp.zeros((ns.shape[0], RWKV_HEADS, RWKV_HEAD_DIM, RWKV_HEAD_DIM), jnp.float32)
    outs_x, outs_s = [], []
    for d in range(2):
        decay_s, kd_s, a_s = dirs_s[d]
        state_ctx, o_s = rwkv_scan(state0, r_s if emit_ctx else None, decay_s, kd_s, vr_s, kk_s, a_s, d == 1)
        decay_x, kd_x, a_x = dirs_x[d]
        _, o_x = rwkv_scan(state_ctx, r_x, decay_x, kd_x, vr_x, kk_x, a_x, d == 1)
        outs_x.append(o_x)
        outs_s.append(o_s)
    rwkv_x = rwkv_readout(outs_x[0], outs_x[1], r_x, dirs_x[0][1], dirs_x[1][1], vr_x, g_x,
                          bonus_u, lnx_gain, lnx_bias)
    y_x = jnp.concatenate([attn_x, rwkv_x.astype(attn_x.dtype)], axis=-1) @ w_out
    if not emit_ctx:
        return y_x, None
    attn_s = context_attention(q_s, k_s, v_s)
    rwkv_s = rwkv_readout(outs_s[0], outs_s[1], r_s, dirs_s[0][1], dirs_s[1][1], vr_s, g_s,
                          bonus_u, lnx_gain, lnx_bias)
    y_s = jnp.concatenate([attn_s, rwkv_s.astype(attn_s.dtype)], axis=-1) @ w_out
    return y_x, y_s


def setup_inputs(seed: int = 0) -> dict:
    key = jax.random.key(seed)
    ks = jax.random.split(key, 25)
    L, D, f32 = DEPTH, D_MODEL, jnp.float32

    def nrm(k, shape, scale):
        return scale * jax.random.normal(k, shape, f32)

    def uni(k, shape, lo, hi):
        return jax.random.uniform(k, shape, f32, lo, hi)

    return {
        'x': nrm(ks[0], (BATCH, SEQ, D), 1.0),
        'c': nrm(ks[1], (BATCH, D), 1.0),
        'ctx': nrm(ks[2], (BATCH, CTX_LEN, D), 1.0),
        'c_ctx': nrm(ks[3], (D,), 1.0),
        'w_mod': nrm(ks[4], (L, D, N_MOD * D), 0.5 * D ** -0.5),
        'b_mod': nrm(ks[5], (L, N_MOD * D), 0.02),
        'norm_gain': 1.0 + nrm(ks[6], (L, 3, D), 0.05),
        'ffn_up': nrm(ks[7], (L, 2, D, 2 * D_FF), D ** -0.5),
        'ffn_down': nrm(ks[8], (L, 2, D_FF, D), D_FF ** -0.5),
        'w_in': nrm(ks[9], (L, D, D_IN), D ** -0.5),
        'q_gain': 1.0 + nrm(ks[10], (L, ATTN_HEAD_DIM), 0.05),
        'k_gain': 1.0 + nrm(ks[11], (L, ATTN_HEAD_DIM), 0.05),
        'na_bias': nrm(ks[12], (L, ATTN_HEADS, 2 * NA_ROWS - 1, 2 * NA_COLS - 1), 0.1),
        'shift_mu': uni(ks[13], (L, RWKV_IN), 0.0, 1.0),
        'decay_w0': uni(ks[14], (L, 2, RWKV_WIDTH), -6.0, -1.0),
        'decay_w2': nrm(ks[15], (L, 2, DECAY_LORA, RWKV_WIDTH), 0.5 * DECAY_LORA ** -0.5),
        'iclr_a0': nrm(ks[16], (L, 2, RWKV_WIDTH), 0.1),
        'iclr_a2': nrm(ks[17], (L, 2, ICLR_LORA, RWKV_WIDTH), ICLR_LORA ** -0.5),
        'gate_g2': nrm(ks[18], (L, GATE_LORA, RWKV_WIDTH), GATE_LORA ** -0.5),
        'key_k': 0.85 + nrm(ks[19], (L, RWKV_WIDTH), 0.05),
        'key_a': 1.0 + nrm(ks[20], (L, RWKV_WIDTH), 0.05),
        'bonus_u': nrm(ks[21], (L, RWKV_HEADS, RWKV_HEAD_DIM), 0.1),
        'lnx_gain': 1.0 + nrm(ks[22], (L, RWKV_WIDTH), 0.05),
        'lnx_bias': nrm(ks[23], (L, RWKV_WIDTH), 0.02),
        'w_out': nrm(ks[24], (L, D, D), D ** -0.5),
    }


def reference(x, c, ctx, c_ctx, w_mod, b_mod, norm_gain, ffn_up, ffn_down, w_in, q_gain,
              k_gain, na_bias, shift_mu, decay_w0, decay_w2, iclr_a0, iclr_a2, gate_g2,
              key_k, key_a, bonus_u, lnx_gain, lnx_bias, w_out):
    s = ctx
    silu_c = jax.nn.silu(c)
    silu_cc = jax.nn.silu(c_ctx)[None, :]
    for l in range(DEPTH):
        last = l == DEPTH - 1
        mx = jnp.split((silu_c @ w_mod[l] + b_mod[l])[:, None, :], N_MOD, axis=-1)
        ms = jnp.split((silu_cc @ w_mod[l] + b_mod[l])[:, None, :], N_MOD, axis=-1)
        x = x + 0.5 * mx[2] * swiglu(modulate(rms_norm(x, norm_gain[l, 0]), mx[0], mx[1]),
                                     ffn_up[l, 0], ffn_down[l, 0])
        s = s + 0.5 * ms[2] * swiglu(modulate(rms_norm(s, norm_gain[l, 0]), ms[0], ms[1]),
                                     ffn_up[l, 0], ffn_down[l, 0])
        nx = modulate(rms_norm(x, norm_gain[l, 1]), mx[3], mx[4])
        ns = modulate(rms_norm(s, norm_gain[l, 1]), ms[3], ms[4])
        y_x, y_s = token_mixing(nx, ns, w_in[l], q_gain[l], k_gain[l], na_bias[l], shift_mu[l],
                                decay_w0[l], decay_w2[l], iclr_a0[l], iclr_a2[l], gate_g2[l],
                                key_k[l], key_a[l], bonus_u[l], lnx_gain[l], lnx_bias[l],
                                w_out[l], not last)
        x = x + mx[5] * y_x
        x = x + 0.5 * mx[8] * swiglu(modulate(rms_norm(x, norm_gain[l, 2]), mx[6], mx[7]),
                                     ffn_up[l, 1], ffn_down[l, 1])
        if not last:
            s = s + ms[5] * y_s
            s = s + 0.5 * ms[8] * swiglu(modulate(rms_norm(s, norm_gain[l, 2]), ms[6], ms[7]),
                                         ffn_up[l, 1], ffn_down[l, 1])
    return x
```

```cpp
#include <hip/hip_runtime.h>
#include <hip/hip_cooperative_groups.h>
#include <cstdio>
namespace cg = cooperative_groups;

#define LAS __attribute__((address_space(3)))
typedef unsigned short bf16_t;
typedef short bf16x8 __attribute__((ext_vector_type(8)));
typedef short bf16x4 __attribute__((ext_vector_type(4)));
typedef float f32x4 __attribute__((ext_vector_type(4)));
typedef float f32x2 __attribute__((ext_vector_type(2)));
typedef unsigned u32x4 __attribute__((ext_vector_type(4)));
typedef unsigned u32x2 __attribute__((ext_vector_type(2)));

constexpr int DM = 1024, MLAT = 16384, MCTX = 1024, MT = 17408, DFF = 2816, DIN = 3328, NLAYER = 4;
constexpr int NTH = 512;
constexpr int LDS_MAIN = 155648;
constexpr int LDS_BYTES = LDS_MAIN + 16;

struct Params {
    const float *x, *c, *ctx, *c_ctx, *w_mod, *b_mod, *norm_gain, *ffn_up, *ffn_down, *w_in, *q_gain, *k_gain, *na_bias, *shift_mu,
        *decay_w0, *decay_w2, *iclr_a0, *iclr_a2, *gate_g2, *key_k, *key_a, *bonus_u, *lnx_gain, *lnx_bias, *w_out;
    float* out;
    float* xc;
    float* mods;
    bf16_t* wb;
    bf16_t* h;
    bf16_t* pa;
    float* pr;
    bf16_t* act;
    float* o;
    bf16_t* vT;
    bf16_t* shh;
    float* dw;
    bf16_t* dkb;
    float* g;
    float* bon;
    float* part;
    bf16_t* lw;
    unsigned* bar;
    int lo, hi;
};

constexpr size_t WB_UP0 = 0, WB_UP1 = 5767168, WB_DN0 = 11534336, WB_DN1 = 14417920, WB_WIN = 17301504, WB_WOUT = 20709376, WB_ELEMS = 21757952;

__device__ __forceinline__ unsigned cvt_pk_bf16(float lo, float hi) { unsigned r; asm volatile("v_cvt_pk_bf16_f32 %0, %1, %2" : "=v"(r) : "v"(lo), "v"(hi)); return r; }
typedef _Float16 f16x8 __attribute__((ext_vector_type(8)));
__device__ __forceinline__ unsigned pk_f16(float lo, float hi) { const _Float16 a = (_Float16)lo, b = (_Float16)hi; return (unsigned)__builtin_bit_cast(unsigned short, a) | ((unsigned)__builtin_bit_cast(unsigned short, b) << 16); }
__device__ __forceinline__ bf16_t f2h(float x) { const _Float16 a = (_Float16)x; return __builtin_bit_cast(unsigned short, a); }
__device__ __forceinline__ float h2f(bf16_t b) { return (float)__builtin_bit_cast(_Float16, b); }
__device__ __forceinline__ bf16_t f2bf(float x) { return (bf16_t)(cvt_pk_bf16(x, 0.f) & 0xffffu); }
__device__ __forceinline__ float bf2f(bf16_t b) { return __uint_as_float(((unsigned)b) << 16); }
template <int CTRL> __device__ __forceinline__ float dppf(float x) { return __builtin_bit_cast(float, __builtin_amdgcn_update_dpp(0, __builtin_bit_cast(int, x), CTRL, 0xf, 0xf, true)); }
__device__ __forceinline__ float swapadd32(float a, float b) {
    asm("s_nop 1\n\tv_permlane32_swap_b32 %0, %1" : "+v"(a), "+v"(b));
    return a + b;
}
__device__ __forceinline__ float swapadd16(float a, float b) {
    asm("s_nop 1\n\tv_permlane16_swap_b32 %0, %1" : "+v"(a), "+v"(b));
    return a + b;
}
__device__ __forceinline__ float red4(float x0, float x1, float x2, float x3) {
    const float y0 = swapadd32(x0, x2), y1 = swapadd32(x1, x3);
    float z = swapadd16(y0, y1);
    z += dppf<0xB1>(z); z += dppf<0x4E>(z); z += dppf<0x124>(z); z += dppf<0x128>(z);
    return z;
}
__device__ __forceinline__ float wave_sum(float v) {
    v += dppf<0xB1>(v); v += dppf<0x4E>(v); v += dppf<0x124>(v); v += dppf<0x128>(v);
    v = swapadd16(v, v); v = swapadd32(v, v);
    return v;
}
__device__ __forceinline__ float wave_max(float v) {
    v = fmaxf(v, dppf<0xB1>(v)); v = fmaxf(v, dppf<0x4E>(v)); v = fmaxf(v, dppf<0x124>(v)); v = fmaxf(v, dppf<0x128>(v));
    { float a = v, b = v; asm("s_nop 1\n\tv_permlane16_swap_b32 %0, %1" : "+v"(a), "+v"(b)); v = fmaxf(a, b); }
    { float a = v, b = v; asm("s_nop 1\n\tv_permlane32_swap_b32 %0, %1" : "+v"(a), "+v"(b)); v = fmaxf(a, b); }
    return v;
}
__device__ __forceinline__ float sigmoidf_(float x) { return 1.0f / (1.0f + expf(-x)); }


#define XB_TMO      128
#define XB_XCNT(j)  (256  + 64 * (j))
#define XB_XSUB(j)  (1280 + 64 * (j))
#define XB_XGEN(j)  (2304 + 64 * (j))
#define XB_TOP      3328
#define XB_TOPGEN   3392
#define XCD_BAR_WORDS 3456
#define XB_SPIN_CAP (1u << 18)
__device__ __forceinline__ unsigned xb_ld(unsigned* p)              { return __hip_atomic_load(p, __ATOMIC_RELAXED, __HIP_MEMORY_SCOPE_AGENT); }
__device__ __forceinline__ unsigned xb_add(unsigned* p, unsigned v) { return __hip_atomic_fetch_add(p, v, __ATOMIC_RELAXED, __HIP_MEMORY_SCOPE_AGENT); }
__device__ __forceinline__ unsigned xb_xcc_id() { return (unsigned)__builtin_amdgcn_s_getreg((3 << 11) | 20) & 0xFu; }
#define XB_SPIN(cond, bar) do { unsigned _sp = 0; while (cond) { __builtin_amdgcn_s_sleep(1); \
    if ((++_sp & 255u) == 0u) { if (xb_ld(&(bar)[XB_TMO])) break; if (_sp > XB_SPIN_CAP) { atomicAdd(&(bar)[XB_TMO], 1u); break; } } } } while (0)
struct XcdBarrier { unsigned* bar; unsigned x; volatile LAS unsigned* st; };
__device__ __forceinline__ XcdBarrier xcd_barrier_post(unsigned* bar, volatile LAS unsigned* st) {
    XcdBarrier b; b.bar = bar; b.x = xb_xcc_id(); b.st = st;
    if (threadIdx.x == 0) (void)xb_add(&bar[XB_XCNT(b.x)], 1u);
    return b;
}
__device__ __forceinline__ void xcd_barrier_complete(unsigned* bar, unsigned x, unsigned& nloc, unsigned& nx) {
    const unsigned G = gridDim.x * gridDim.y * gridDim.z;
    unsigned sum, cnt, mine, sp = 0u;
    for (;;) {
        sum = 0u; cnt = 0u; mine = 0u;
#pragma unroll
        for (unsigned j = 0; j < 16; ++j) { const unsigned c = xb_ld(&bar[XB_XCNT(j)]); sum += c; cnt += (c > 0u) ? 1u : 0u; mine = (j == x) ? c : mine; }
        if (sum == G) break;
        __builtin_amdgcn_s_sleep(1);
        if ((++sp & 255u) == 0u) { if (xb_ld(&bar[XB_TMO])) break; if (sp > XB_SPIN_CAP) { atomicAdd(&bar[XB_TMO], 1u); break; } }
    }
    nloc = mine > 0u ? mine : 1u; nx = cnt > 0u ? cnt : 1u;
}
__device__ __forceinline__ void xcd_barrier(const XcdBarrier& b, const int tid) {
    asm volatile("s_waitcnt vmcnt(0)" ::: "memory");
    __syncthreads();
    if (tid == 0) {
        unsigned* bar = b.bar;
        __builtin_amdgcn_s_waitcnt(0);
        unsigned nloc = b.st[0], nx = b.st[1];
        if (nloc == 0u) { xcd_barrier_complete(bar, b.x, nloc, nx); b.st[0] = nloc; b.st[1] = nx; }
        const unsigned old = xb_add(&bar[XB_XSUB(b.x)], 1u);
        const unsigned gen = old / nloc;
        if (old + 1u == (gen + 1u) * nloc) {
            __builtin_amdgcn_fence(__ATOMIC_RELEASE, "agent");
            asm volatile("s_waitcnt vmcnt(0)" ::: "memory");
            const unsigned og = xb_add(&bar[XB_TOP], 1u);
            const unsigned tg = og / nx;
            if (og + 1u == (tg + 1u) * nx) xb_add(&bar[XB_TOPGEN], 1u);
            else XB_SPIN(xb_ld(&bar[XB_TOPGEN]) == tg, bar);
            __builtin_amdgcn_fence(__ATOMIC_ACQUIRE, "agent");
            xb_add(&bar[XB_XGEN(b.x)], 1u);
            asm volatile("s_waitcnt vmcnt(0)" ::: "memory");
        } else {
            XB_SPIN(xb_ld(&bar[XB_XGEN(b.x)]) == gen, bar);
            __builtin_amdgcn_fence(__ATOMIC_ACQUIRE, "agent");
            asm volatile("s_waitcnt vmcnt(0)" ::: "memory");
        }
    }
    __syncthreads();
}

namespace pg8 {
constexpr int BM = 256, BK = 64, HALF = 128, HTB = HALF * BK * 2, STAGE_BYTES = 8 * HTB, NXCD = 8, WGM = 8;
__host__ __device__ __forceinline__ int lds_byte(int r, int c) { const int st = (r >> 4) * 2 + (c >> 5), rr = r & 15, cc = c & 31, ob = rr * 64 + cc * 2; return st * 1024 + (ob ^ (((ob >> 9) & 1) << 5)); }
__host__ __device__ __forceinline__ void stage_rc(int b, int& R, int& C) { const int st = b / 1024, sb = b % 1024, swz = sb ^ (((sb >> 9) & 1) << 5); R = (st >> 1) * 16 + swz / 64; C = (st & 1) * 32 + (swz % 64) / 2; }
__host__ __device__ __forceinline__ int perm32(int rho) { const int n = rho >> 4, i = rho & 15; return 8 * (i >> 2) + 4 * n + (i & 3); }
struct Unit { int pm, pn, kofs, nt, split; };
struct Gemm { const bf16_t* A; const bf16_t* Bt; int M, N, K; };
struct StaticOrder {
    int nM, nN, nwg, G, c, ntk, nsl;
    __device__ void init(int M, int N, int K, int G_, int c_, int nsl_) { nM = M / BM; nN = N / BM; nwg = nM * nN; G = G_; c = c_; ntk = K / BK; nsl = nsl_; }
    __device__ bool next(int i, Unit& u) const {
        const long L = (long)i * G + c;
        if (L >= nwg) {
            const int s = (int)(L - nwg); if (s >= 16 * nsl) return false;
            const int cu = s / nsl, sl = s - cu * nsl, np = ntk >> 1, q = np / nsl, r = np - q * nsl;
            u.pm = 64 + (cu >> 2); u.pn = cu & 3; u.kofs = (sl * q + (sl < r ? sl : r)) * 128; u.nt = 2 * (q + (sl < r ? 1 : 0)); u.split = sl + 1; return true;
        }
        int wgid = (int)L; { const int q = nwg / NXCD, r = nwg % NXCD, xcd = wgid % NXCD, off = wgid / NXCD; wgid = (xcd < r ? xcd * (q + 1) : r * (q + 1) + (xcd - r) * q) + off; }
        const int nig = WGM * nN, gid = wgid / nig, fm = gid * WGM, gsz = (nM - fm) < WGM ? (nM - fm) : WGM;
        u.pm = fm + ((wgid % nig) % gsz); u.pn = (wgid % nig) / gsz; u.kofs = 0; u.nt = ntk; u.split = 0; return true;
    }
};

template <class Epi, bool ALIGN_EPI = true, bool SP2 = true>
__device__ __forceinline__ void gemm_phase(LAS unsigned char* lds, const Gemm g, const StaticOrder& S, const Epi& E, const int tid) {
    const int wid = __builtin_amdgcn_readfirstlane(tid >> 6), lane = tid & 63, wr = wid >> 2, wc = wid & 3, fr = lane & 15, fq = lane >> 4;
    const int K = g.K;
    unsigned voffA[2], voffB[2];
#pragma unroll
    for (int i = 0; i < 2; ++i) { int R, C; stage_rc(tid * 16 + i * 8192, R, C); const int Rb = Epi::PERM ? ((R & ~31) + perm32(R & 31)) : R;
        voffA[i] = (unsigned)(R * K + C) * 2u; voffB[i] = (unsigned)(Rb * K + C) * 2u; }
    const size_t kstep = (size_t)(BK * 2);
    const size_t hstep = (size_t)HALF * K * 2;
    const size_t tstep = 2 * hstep;
    const unsigned ldsw = (unsigned)wid * 1024u;
    const int aoff = lds_byte(wr * 64 + fr, fq * 8), boff = lds_byte(wc * 32 + fr, fq * 8);
#define PG8_SA(b, h) (((b) * 2 + (h)) * HTB)
#define PG8_SB(b, h) ((4 + (b) * 2 + (h)) * HTB)
#define PG8_STAGE(bufoff, gbase, voff) do { _Pragma("unroll") for (int _i = 0; _i < 2; ++_i) \
        __builtin_amdgcn_global_load_lds((const unsigned*)((const char*)(gbase) + (voff)[_i]), (LAS unsigned*)(lds + (bufoff) + ldsw + _i * 8192), 16, 0, 0); } while (0)
#define PG8_LDA(dst, b, h) do { _Pragma("unroll") for (int m = 0; m < 4; ++m) _Pragma("unroll") for (int k = 0; k < 2; ++k) dst[m][k] = *(const LAS bf16x8*)(lds + PG8_SA(b, h) + aoff + m * 2048 + k * 1024); } while (0)
#define PG8_LDB(dst, b, h) do { _Pragma("unroll") for (int n = 0; n < 2; ++n) _Pragma("unroll") for (int k = 0; k < 2; ++k) dst[n][k] = *(const LAS bf16x8*)(lds + PG8_SB(b, h) + boff + n * 2048 + k * 1024); } while (0)
#define PG8_MMA(ai, bj, At, Bt) do { __builtin_amdgcn_s_setprio(1); _Pragma("unroll") for (int m = 0; m < 4; ++m) _Pragma("unroll") for (int n = 0; n < 2; ++n) _Pragma("unroll") for (int k = 0; k < 2; ++k) \
        acc[ai][bj][m][n] = __builtin_amdgcn_mfma_f32_16x16x32_bf16(Bt[n][k], At[m][k], acc[ai][bj][m][n], 0, 0, 0); __builtin_amdgcn_s_setprio(0); } while (0)
#define PG8_WAIT_V(n) asm volatile("s_waitcnt vmcnt(" #n ")" ::: "memory")
#define PG8_WAIT_L(n) asm volatile("s_waitcnt lgkmcnt(" #n ")" ::: "memory")
#define PG8_BAR __builtin_amdgcn_s_barrier()
#define PG8_SCHED __builtin_amdgcn_sched_barrier(0)
    Unit cur, nxt; int ui = 0;
    if (!S.next(0, cur)) return;
    f32x4 acc[2][2][4][2];
#pragma unroll
    for (int a = 0; a < 2; ++a)
#pragma unroll
        for (int b = 0; b < 2; ++b)
#pragma unroll
            for (int m = 0; m < 4; ++m)
#pragma unroll
                for (int n = 0; n < 2; ++n) acc[a][b][m][n] = (f32x4){0.f, 0.f, 0.f, 0.f};
    bf16x8 At[4][2], B0[2][2], B1[2][2];
    const char* cA = (const char*)g.A + (size_t)cur.pm * tstep + (size_t)cur.kofs * 2; const char* cB = (const char*)g.Bt + (size_t)cur.pn * tstep + (size_t)cur.kofs * 2;
    if constexpr (SP2) {
        PG8_STAGE(PG8_SB(0, 0), cB, voffB); PG8_STAGE(PG8_SB(0, 1), cB + hstep, voffB); PG8_STAGE(PG8_SA(0, 0), cA, voffA); PG8_STAGE(PG8_SA(0, 1), cA + hstep, voffA);
        if (wr == 1) PG8_BAR;
        PG8_WAIT_V(2); PG8_BAR;
        PG8_STAGE(PG8_SB(1, 0), cB + kstep, voffB); PG8_STAGE(PG8_SA(1, 0), cA + kstep, voffA); PG8_STAGE(PG8_SB(1, 1), cB + hstep + kstep, voffB);
        PG8_WAIT_V(6); PG8_BAR;
    } else {
        PG8_STAGE(PG8_SB(0, 0), cB, voffB); PG8_STAGE(PG8_SA(0, 0), cA, voffA); PG8_STAGE(PG8_SB(0, 1), cB + hstep, voffB); PG8_STAGE(PG8_SA(0, 1), cA + hstep, voffA);
        if (wr == 1) PG8_BAR;
        PG8_WAIT_V(4); PG8_BAR;
        PG8_STAGE(PG8_SB(1, 0), cB + kstep, voffB); PG8_STAGE(PG8_SA(1, 0), cA + kstep, voffA); PG8_STAGE(PG8_SB(1, 1), cB + hstep + kstep, voffB);
        PG8_WAIT_V(6); PG8_BAR;
    }
    for (;;) {
        const bool has_next = S.next(ui + 1, nxt);
        const char* nA = has_next ? (const char*)g.A + (size_t)nxt.pm * tstep + (size_t)nxt.kofs * 2 : cA; const char* nB = has_next ? (const char*)g.Bt + (size_t)nxt.pn * tstep + (size_t)nxt.kofs * 2 : cB;
        const int nt = cur.nt;
        for (int t = 0; t < nt; t += 2) {
            const bool last = (t == nt - 2);
            const char* a1 = cA + (size_t)(t + 1) * kstep;
            const char* a2 = last ? nA : cA + (size_t)(t + 2) * kstep; const char* b2 = last ? nB : cB + (size_t)(t + 2) * kstep;
            const char* a3 = a2 + kstep; const char* b3 = b2 + kstep;
            if constexpr (SP2) {
            PG8_LDB(B0, 0, 0); PG8_LDB(B1, 0, 1); PG8_SCHED; PG8_LDA(At, 0, 0); PG8_STAGE(PG8_SA(1, 1), a1 + hstep, voffA);
            PG8_WAIT_V(8); PG8_WAIT_L(0); PG8_BAR; PG8_MMA(0, 0, At, B0); PG8_MMA(0, 1, At, B1); PG8_BAR; PG8_SCHED;
            PG8_LDA(At, 0, 1); PG8_STAGE(PG8_SB(0, 0), b2, voffB); PG8_STAGE(PG8_SB(0, 1), b2 + hstep, voffB); PG8_STAGE(PG8_SA(0, 0), a2, voffA);
            PG8_WAIT_V(8); PG8_WAIT_L(0); PG8_BAR; PG8_MMA(1, 0, At, B0); PG8_MMA(1, 1, At, B1); PG8_BAR; PG8_SCHED;
            PG8_LDB(B0, 1, 0); PG8_LDB(B1, 1, 1); PG8_SCHED; PG8_LDA(At, 1, 0); PG8_STAGE(PG8_SA(0, 1), a2 + hstep, voffA);
            PG8_WAIT_V(8); PG8_WAIT_L(0); PG8_BAR; PG8_MMA(0, 0, At, B0); PG8_MMA(0, 1, At, B1); PG8_BAR; PG8_SCHED;
            PG8_LDA(At, 1, 1); PG8_STAGE(PG8_SB(1, 0), b3, voffB); PG8_STAGE(PG8_SB(1, 1), b3 + hstep, voffB); PG8_STAGE(PG8_SA(1, 0), a3, voffA);
            PG8_WAIT_V(8); PG8_WAIT_L(0); PG8_BAR; PG8_MMA(1, 0, At, B0); PG8_MMA(1, 1, At, B1); PG8_BAR; PG8_SCHED;
            } else {
            PG8_LDB(B0, 0, 0); PG8_SCHED; PG8_LDA(At, 0, 0); PG8_STAGE(PG8_SA(1, 1), a1 + hstep, voffA);
            PG8_WAIT_L(8); PG8_BAR; PG8_WAIT_L(0); PG8_MMA(0, 0, At, B0); PG8_BAR; PG8_SCHED;
            PG8_LDB(B1, 0, 1); PG8_STAGE(PG8_SB(0, 0), b2, voffB);
            PG8_BAR; PG8_WAIT_L(0); PG8_MMA(0, 1, At, B1); PG8_BAR;
            PG8_LDA(At, 0, 1); PG8_STAGE(PG8_SA(0, 0), a2, voffA);
            PG8_BAR; PG8_WAIT_L(0); PG8_MMA(1, 0, At, B0); PG8_BAR; PG8_SCHED;
            PG8_STAGE(PG8_SB(0, 1), b2 + hstep, voffB);
            PG8_WAIT_V(6); PG8_BAR; PG8_MMA(1, 1, At, B1); PG8_BAR;
            PG8_LDB(B0, 1, 0); PG8_SCHED; PG8_LDA(At, 1, 0); PG8_STAGE(PG8_SA(0, 1), a2 + hstep, voffA);
            PG8_WAIT_L(8); PG8_BAR; PG8_WAIT_L(0); PG8_MMA(0, 0, At, B0); PG8_BAR; PG8_SCHED;
            PG8_LDB(B1, 1, 1); PG8_STAGE(PG8_SB(1, 0), b3, voffB);
            PG8_BAR; PG8_WAIT_L(0); PG8_MMA(0, 1, At, B1); PG8_BAR;
            PG8_LDA(At, 1, 1); PG8_STAGE(PG8_SA(1, 0), a3, voffA);
            PG8_BAR; PG8_WAIT_L(0); PG8_MMA(1, 0, At, B0); PG8_BAR; PG8_SCHED;
            PG8_STAGE(PG8_SB(1, 1), b3 + hstep, voffB);
            PG8_WAIT_V(6); PG8_BAR; PG8_MMA(1, 1, At, B1); PG8_BAR;
            }
        }
        if constexpr (ALIGN_EPI) { if (wr == 0) PG8_BAR; }
        { int e_fr = fr, e_fq = fq, e_wr = wr, e_wc = wc; asm volatile("" : "+v"(e_fr), "+v"(e_fq), "+s"(e_wr), "+s"(e_wc));
          E(acc, cur, e_wr, e_wc, e_fr, e_fq); }
        if (!has_next) break;
#pragma unroll
        for (int a = 0; a < 2; ++a)
#pragma unroll
            for (int b = 0; b < 2; ++b)
#pragma unroll
                for (int m = 0; m < 4; ++m)
#pragma unroll
                    for (int n = 0; n < 2; ++n) acc[a][b][m][n] = (f32x4){0.f, 0.f, 0.f, 0.f};
        cur = nxt; cA = nA; cB = nB; ++ui;
        if constexpr (ALIGN_EPI) { if (wr == 1) PG8_BAR; }
    }
    PG8_WAIT_V(0);
    if constexpr (!ALIGN_EPI) { if (wr == 0) PG8_BAR; }
    PG8_BAR;
#undef PG8_SA
#undef PG8_SB
#undef PG8_STAGE
#undef PG8_LDA
#undef PG8_LDB
#undef PG8_MMA
#undef PG8_WAIT_V
#undef PG8_WAIT_L
#undef PG8_BAR
#undef PG8_SCHED
}
}

struct EpiSwiglu {
    static constexpr bool PERM = true;
    bf16_t* O;
    __device__ __forceinline__ void operator()(const f32x4 (&acc)[2][2][4][2], const pg8::Unit& u, int wr, int wc, int fr, int fq) const {
        const int row0 = u.pm * 256 + wr * 64 + fr, col0 = u.pn * 128 + wc * 32 + 8 * fq;
#pragma unroll
        for (int ai = 0; ai < 2; ++ai)
#pragma unroll
            for (int m = 0; m < 4; ++m) {
                bf16_t* rowp = O + (size_t)(row0 + ai * 128 + m * 16) * DFF + col0;
                float v[8];
#pragma unroll
                for (int n = 0; n < 2; ++n)
#pragma unroll
                    for (int j = 0; j < 4; ++j) { const float gt = acc[ai][0][m][n][j], up = acc[ai][1][m][n][j]; v[n * 4 + j] = gt * __builtin_amdgcn_rcpf(1.0f + __expf(-gt)) * up; }
                u32x4 w; w.x = cvt_pk_bf16(v[0], v[1]); w.y = cvt_pk_bf16(v[2], v[3]); w.z = cvt_pk_bf16(v[4], v[5]); w.w = cvt_pk_bf16(v[6], v[7]);
                *(u32x4*)rowp = w;
            }
    }
};
struct EpiResid {
    static constexpr bool PERM = false;
    float* xlat; float* xctx; const float* mods_l; int gidx; float scale; float* part; const float* xlat_src;
    __device__ __forceinline__ void operator()(const f32x4 (&acc)[2][2][4][2], const pg8::Unit& u, int wr, int wc, int fr, int fq) const {
        if (u.split) {
            float* pb = part + ((size_t)(u.split - 1) * MCTX + (size_t)(u.pm - 64) * 256) * DM + u.pn * 256 + wc * 32 + 4 * fq;
#pragma unroll
            for (int ai = 0; ai < 2; ++ai)
#pragma unroll
                for (int m = 0; m < 4; ++m) { float* rowp = pb + (size_t)(wr * 64 + fr + ai * 128 + m * 16) * DM;
#pragma unroll
                    for (int bj = 0; bj < 2; ++bj)
#pragma unroll
                        for (int n = 0; n < 2; ++n) *(f32x4*)(rowp + bj * 128 + n * 16) = acc[ai][bj][m][n]; }
            return;
        }
        const int s = u.pm < 64 ? (u.pm >> 4) : 4;
        const float* gate = mods_l + s * 9216 + gidx * 1024;
        float* base = u.pm < 64 ? xlat + (size_t)(u.pm * 256) * DM : xctx + (size_t)((u.pm - 64) * 256) * DM;
        const float* sbase = u.pm < 64 ? xlat_src + (size_t)(u.pm * 256) * DM : base;
        const int col0 = u.pn * 256 + wc * 32 + 4 * fq;
        f32x4 gv[2][2];
#pragma unroll
        for (int bj = 0; bj < 2; ++bj)
#pragma unroll
            for (int n = 0; n < 2; ++n) gv[bj][n] = *(const f32x4*)(gate + col0 + bj * 128 + n * 16) * scale;
#pragma unroll
        for (int ai = 0; ai < 2; ++ai) {
            f32x4 xv[4][2][2];
#pragma unroll
            for (int m = 0; m < 4; ++m) { const float* rowp = sbase + (size_t)(wr * 64 + fr + ai * 128 + m * 16) * DM + col0;
#pragma unroll
                for (int bj = 0; bj < 2; ++bj)
#pragma unroll
                    for (int n = 0; n < 2; ++n) xv[m][bj][n] = *(const f32x4*)(rowp + bj * 128 + n * 16); }
#pragma unroll
            for (int m = 0; m < 4; ++m) { float* rowp = base + (size_t)(wr * 64 + fr + ai * 128 + m * 16) * DM + col0;
#pragma unroll
                for (int bj = 0; bj < 2; ++bj)
#pragma unroll
                    for (int n = 0; n < 2; ++n) *(f32x4*)(rowp + bj * 128 + n * 16) = xv[m][bj][n] + gv[bj][n] * acc[ai][bj][m][n]; }
            asm volatile("" ::: "memory");
        }
    }
};
struct EpiWin {
    static constexpr bool PERM = true;
    bf16_t* pa; float* pr;
    __device__ __forceinline__ void operator()(const f32x4 (&acc)[2][2][4][2], const pg8::Unit& u, int wr, int wc, int fr, int fq) const {
        const int row0 = u.pm * 256 + wr * 64 + fr;
        if (u.pn < 6) {
            const int col0 = u.pn * 256 + wc * 32 + 8 * fq;
#pragma unroll
            for (int ai = 0; ai < 2; ++ai)
#pragma unroll
                for (int m = 0; m < 4; ++m) { bf16_t* rowp = pa + (size_t)(row0 + ai * 128 + m * 16) * 1536 + col0;
#pragma unroll
                    for (int bj = 0; bj < 2; ++bj) { const f32x4 a = acc[ai][bj][m][0], b = acc[ai][bj][m][1];
                        u32x4 w; w.x = cvt_pk_bf16(a[0], a[1]); w.y = cvt_pk_bf16(a[2], a[3]); w.z = cvt_pk_bf16(b[0], b[1]); w.w = cvt_pk_bf16(b[2], b[3]);
                        *(u32x4*)(rowp + bj * 128) = w; } }
        } else {
            const int col0 = (u.pn - 6) * 256 + wc * 32 + 8 * fq;
#pragma unroll
            for (int ai = 0; ai < 2; ++ai)
#pragma unroll
                for (int m = 0; m < 4; ++m) { float* rowp = pr + (size_t)(row0 + ai * 128 + m * 16) * 1792 + col0;
#pragma unroll
                    for (int bj = 0; bj < 2; ++bj)
#pragma unroll
                        for (int n = 0; n < 2; ++n) *(f32x4*)(rowp + bj * 128 + n * 4) = acc[ai][bj][m][n]; }
        }
    }
};

__device__ __forceinline__ const float* xrow_c(const Params& p, int r) { return r < MLAT ? p.out + (size_t)r * DM : p.xc + (size_t)(r - MLAT) * DM; }

__device__ __forceinline__ void phase_init(const Params& p, float* ldsf, const int tid, const int bid) {
    const int wid = tid >> 6, lane = tid & 63;
    for (int i = tid; i < 5 * DM; i += NTH) { const int s = i >> 10, k = i & 1023; const float v = s < 4 ? p.c[s * DM + k] : p.c_ctx[k]; ldsf[i] = v * sigmoidf_(v); }
    __syncthreads();
    float* part = ldsf + 5 * DM;
    for (int it = bid; it < NLAYER * 144; it += gridDim.x) {
        const int l = it / 144, n0 = (it % 144) * 64;
        const float* w = p.w_mod + ((size_t)l * DM + wid * 128) * 9216 + n0 + lane;
        float a0 = 0, a1 = 0, a2 = 0, a3 = 0, a4 = 0;
#pragma unroll 16
        for (int i = 0; i < 128; ++i) { const float wv = __builtin_nontemporal_load(w + (size_t)i * 9216); const int k = wid * 128 + i;
            a0 += ldsf[k] * wv; a1 += ldsf[DM + k] * wv; a2 += ldsf[2 * DM + k] * wv; a3 += ldsf[3 * DM + k] * wv; a4 += ldsf[4 * DM + k] * wv; }
        part[(wid * 5 + 0) * 64 + lane] = a0; part[(wid * 5 + 1) * 64 + lane] = a1; part[(wid * 5 + 2) * 64 + lane] = a2; part[(wid * 5 + 3) * 64 + lane] = a3; part[(wid * 5 + 4) * 64 + lane] = a4;
        __syncthreads();
        if (tid < 320) { const int s = tid >> 6; float v = p.b_mod[l * 9216 + n0 + lane];
#pragma unroll
            for (int q = 0; q < 8; ++q) v += part[(q * 5 + s) * 64 + lane];
            p.mods[((size_t)l * 5 + s) * 9216 + n0 + lane] = v; }
        __syncthreads();
    }
}

struct ConvTile { const float* src; bf16_t* dst; int K, N, mode, k0, n0; };
__device__ __forceinline__ ConvTile conv_decode(const Params& p, int l, int t) {
    ConvTile c; c.mode = 0;
    if (t < 2816) { const int i = t / 1408; t %= 1408; c.src = p.ffn_up + ((size_t)(l * 2 + i)) * DM * 5632; c.dst = p.wb + (i ? WB_UP1 : WB_UP0); c.K = DM; c.N = 5632; c.mode = 1; }
    else if (t < 4224) { t -= 2816; const int i = t / 704; t %= 704; c.src = p.ffn_down + ((size_t)(l * 2 + i)) * DFF * DM; c.dst = p.wb + (i ? WB_DN1 : WB_DN0); c.K = DFF; c.N = DM; }
    else if (t < 5056) { t -= 4224; c.src = p.w_in + (size_t)l * DM * DIN; c.dst = p.wb + WB_WIN; c.K = DM; c.N = DIN; }
    else if (t < 5312) { t -= 5056; c.src = p.w_out + (size_t)l * DM * DM; c.dst = p.wb + WB_WOUT; c.K = DM; c.N = DM; }
    else { t -= 5312; c.mode = 2; c.N = 512;
        if (t < 16) { const int d = t >> 3; t &= 7; c.src = p.decay_w2 + (size_t)(l * 2 + d) * 64 * 512; c.dst = p.lw + d * 32768; c.K = 64; }
        else if (t < 32) { t -= 16; const int d = t >> 3; t &= 7; c.src = p.iclr_a2 + (size_t)(l * 2 + d) * 64 * 512; c.dst = p.lw + 65536 + d * 32768; c.K = 64; }
        else { t -= 32; c.src = p.gate_g2 + (size_t)l * 128 * 512; c.dst = p.lw + 131072; c.K = 128; } }
    const int ntn = c.N / 64, tk = t / ntn, tn = t - tk * ntn; c.k0 = tk * 64; c.n0 = tn * 64;
    return c;
}
__device__ __forceinline__ void phase_convert(const Params& p, int l, float* tile, const int tid, const int bid) {
    const int ty = tid >> 6, tx = tid & 63;
    float cur[8], nxt[8];
    if (bid < 5360) { const ConvTile c = conv_decode(p, l, bid);
#pragma unroll
        for (int i = 0; i < 8; ++i) cur[i] = __builtin_nontemporal_load(c.src + (size_t)(c.k0 + ty + 8 * i) * c.N + c.n0 + tx); }
    for (int it = bid; it < 5360; it += gridDim.x) {
        const int itn = it + gridDim.x;
        if (itn < 5360) { const ConvTile cn = conv_decode(p, l, itn);
#pragma unroll
            for (int i = 0; i < 8; ++i) nxt[i] = __builtin_nontemporal_load(cn.src + (size_t)(cn.k0 + ty + 8 * i) * cn.N + cn.n0 + tx); }
        const ConvTile c = conv_decode(p, l, it);
#pragma unroll
        for (int i = 0; i < 8; ++i) tile[(ty + 8 * i) * 65 + tx] = cur[i];
        __syncthreads();
        const int nl = tid >> 3, kc = tid & 7, n = c.n0 + nl;
        const int row = c.mode == 1 ? (n < DFF ? ((n >> 7) * 256 + (n & 127)) : (((n - DFF) >> 7) * 256 + 128 + ((n - DFF) & 127))) : n;
        float v[8];
#pragma unroll
        for (int j = 0; j < 8; ++j) v[j] = tile[(kc * 8 + j) * 65 + nl];
        u32x4 w;
        if (c.mode == 2) { w.x = pk_f16(v[0], v[1]); w.y = pk_f16(v[2], v[3]); w.z = pk_f16(v[4], v[5]); w.w = pk_f16(v[6], v[7]); }
        else { w.x = cvt_pk_bf16(v[0], v[1]); w.y = cvt_pk_bf16(v[2], v[3]); w.z = cvt_pk_bf16(v[4], v[5]); w.w = cvt_pk_bf16(v[6], v[7]); }
        *(u32x4*)(c.dst + (size_t)row * c.K + c.k0 + kc * 8) = w;
        __syncthreads();
#pragma unroll
        for (int i = 0; i < 8; ++i) cur[i] = nxt[i];
    }
}

__device__ __forceinline__ void phase_norm(const Params& p, int l, int which, const int tid, const int bid, const int npart, const float* pgate, const float pscale, const float* xlsrc, const float* xcsrc) {
    const int wid = tid >> 6, lane = tid & 63;
    const float* gain = p.norm_gain + (size_t)(l * 3 + which) * DM;
#pragma unroll 2
    for (int r = bid * 8 + wid; r < MT; r += gridDim.x * 8) {
        const float* xr = r < MLAT ? xlsrc + (size_t)r * DM : xcsrc + (size_t)(r - MLAT) * DM;
        const int s = r < MLAT ? (r >> 12) : 4;
        const float* md = p.mods + ((size_t)l * 5 + s) * 9216;
        const float* shift = md + (3 * which) * DM; const float* scale = md + (3 * which + 1) * DM;
        f32x4 v[4]; float ss = 0.f;
#pragma unroll
        for (int i = 0; i < 4; ++i) { v[i] = *(const f32x4*)(xr + (lane + 64 * i) * 4);
            if (r >= MLAT && npart > 0) {
                f32x4 a = {0.f, 0.f, 0.f, 0.f};
                for (int q = 0; q < npart; ++q) a += *(const f32x4*)(p.part + ((size_t)q * MCTX + (r - MLAT)) * DM + (lane + 64 * i) * 4);
                v[i] += a * (*(const f32x4*)(pgate + (lane + 64 * i) * 4)) * pscale;
                *(f32x4*)(p.xc + (size_t)(r - MLAT) * DM + (lane + 64 * i) * 4) = v[i];
            }
            ss += v[i][0] * v[i][0] + v[i][1] * v[i][1] + v[i][2] * v[i][2] + v[i][3] * v[i][3]; }
        ss = wave_sum(ss);
        const float rstd = rsqrtf(ss * (1.0f / DM) + 1e-6f);
#pragma unroll
        for (int i = 0; i < 4; ++i) { const int c = (lane + 64 * i) * 4;
            const f32x4 gn = *(const f32x4*)(gain + c), sc = *(const f32x4*)(scale + c), sf = *(const f32x4*)(shift + c);
            f32x4 y = (v[i] * rstd) * gn; y = y * (1.0f + sc) + sf;
            u32x2 w; w.x = cvt_pk_bf16(y[0], y[1]); w.y = cvt_pk_bf16(y[2], y[3]);
            *(u32x2*)(p.h + (size_t)r * DM + c) = w; }
    }
}

__device__ __forceinline__ void phase_prep(const Params& p, int l, float* lin, const int tid, const int bid) {
    const int wid = tid >> 6, lane = tid & 63, c = tid;
    const float* mu = p.shift_mu + (size_t)l * 1792;
    const float mu_r = mu[c], mu_k = mu[512 + c], mu_v = mu[1024 + c];
    const float kkc = p.key_k[l * 512 + c], kac = p.key_a[l * 512 + c], uc = p.bonus_u[l * 512 + c];
    const float w0f = p.decay_w0[(l * 2 + 0) * 512 + c], w0b = p.decay_w0[(l * 2 + 1) * 512 + c];
    const float a0f = p.iclr_a0[(l * 2 + 0) * 512 + c], a0b = p.iclr_a0[(l * 2 + 1) * 512 + c];
    const float qgn = p.q_gain[l * 64 + lane] * 0.125f, kgn = p.k_gain[l * 64 + lane];
    const float* dw2f = p.decay_w2 + (size_t)(l * 2 + 0) * 64 * 512 + c; const float* dw2b = p.decay_w2 + (size_t)(l * 2 + 1) * 64 * 512 + c;
    const float* ia2f = p.iclr_a2 + (size_t)(l * 2 + 0) * 64 * 512 + c; const float* ia2b = p.iclr_a2 + (size_t)(l * 2 + 1) * 64 * 512 + c;
    const float* gg2 = p.gate_g2 + (size_t)l * 128 * 512 + c;
    for (int tile = bid; tile < 1024 + 256; tile += gridDim.x) {
        const int t0 = tile < 1024 ? tile * 16 : MLAT + (tile - 1024) * 4, ntok = tile < 1024 ? 16 : 4;
        int seq_lo, seq_hi;
        if (t0 < MLAT) { seq_lo = t0 & ~4095; seq_hi = seq_lo + 4096; } else { seq_lo = MLAT + ((t0 - MLAT) & ~255); seq_hi = seq_lo + 256; }
        __syncthreads();
#pragma unroll
        for (int i = 0; i < 8; ++i) {
            const int idx = tid + NTH * i, tt = idx >> 8, j = idx & 255, t = t0 + tt;
            if (tt >= ntok) continue;
            const float pc = p.pr[(size_t)t * 1792 + 1536 + j];
            const float pm = t > seq_lo ? p.pr[(size_t)(t - 1) * 1792 + 1536 + j] : 0.f;
            const float pp = t + 1 < seq_hi ? p.pr[(size_t)(t + 1) * 1792 + 1536 + j] : 0.f;
            const float xs = pc + mu[1536 + j] * (0.5f * (pm + pp) - pc);
            const float f = j < 64 ? (1.0f - 2.0f * __builtin_amdgcn_rcpf(1.0f + __expf(2.0f * xs))) : (j < 128 ? xs : __builtin_amdgcn_rcpf(1.0f + __expf(-xs)));
            ((_Float16*)lin)[tt * 264 + j] = (_Float16)f;
        }
        __syncthreads();
        float dwf[16], dwb[16], af[16], ab[16], gg[16];
        {
            const int fr = lane & 15, fq = lane >> 4;
            const _Float16* linh = (const _Float16*)lin;
            bf16_t* outh = (bf16_t*)(lin + 4096);
            const bf16_t* lwp = p.lw;
#pragma unroll
            for (int m = 0; m < 5; ++m) {
                const int KK = m < 4 ? 64 : 128, jofs = m < 2 ? 0 : (m < 4 ? 64 : 128);
                const bf16_t* wbase = lwp + (size_t)m * 32768;
#pragma unroll
                for (int ct = 0; ct < 4; ++ct) {
                    f32x4 acc = {0.f, 0.f, 0.f, 0.f};
#pragma unroll
                    for (int ks = 0; ks < 4; ++ks) {
                        if (ks * 32 < KK) {
                            const f16x8 a = *(const f16x8*)(linh + fr * 264 + jofs + ks * 32 + fq * 8);
                            const f16x8 bfr = *(const f16x8*)(wbase + (size_t)(wid * 64 + ct * 16 + fr) * KK + ks * 32 + fq * 8);
                            acc = __builtin_amdgcn_mfma_f32_16x16x32_f16(a, bfr, acc, 0, 0, 0);
                        }
                    }
#pragma unroll
                    for (int r = 0; r < 4; ++r) outh[(m * 16 + fq * 4 + r) * 520 + wid * 64 + ct * 16 + fr] = f2h(acc[r]);
                }
            }
            __syncthreads();
#pragma unroll
            for (int tt = 0; tt < 16; ++tt) {
                dwf[tt] = h2f(outh[(0 * 16 + tt) * 520 + c]); dwb[tt] = h2f(outh[(1 * 16 + tt) * 520 + c]);
                af[tt] = h2f(outh[(2 * 16 + tt) * 520 + c]); ab[tt] = h2f(outh[(3 * 16 + tt) * 520 + c]);
                gg[tt] = h2f(outh[(4 * 16 + tt) * 520 + c]);
            }
        }
        const float* prr = p.pr + c;
        float r_prev = t0 > seq_lo ? prr[(size_t)(t0 - 1) * 1792] : 0.f, r_cur = prr[(size_t)t0 * 1792];
        float k_prev = t0 > seq_lo ? prr[(size_t)(t0 - 1) * 1792 + 512] : 0.f, k_cur = prr[(size_t)t0 * 1792 + 512];
        float v_prev = t0 > seq_lo ? prr[(size_t)(t0 - 1) * 1792 + 1024] : 0.f, v_cur = prr[(size_t)t0 * 1792 + 1024];
        const bool h1 = t0 + 1 < seq_hi;
        float r_nx = h1 ? prr[(size_t)(t0 + 1) * 1792] : 0.f, k_nx = h1 ? prr[(size_t)(t0 + 1) * 1792 + 512] : 0.f, v_nx = h1 ? prr[(size_t)(t0 + 1) * 1792 + 1024] : 0.f;
        unsigned short pq_n = p.pa[(size_t)t0 * 1536 + c], pk_n = p.pa[(size_t)t0 * 1536 + 512 + c], pv_n = p.pa[(size_t)t0 * 1536 + 1024 + c];
        unsigned vtp[8] = {0u, 0u, 0u, 0u, 0u, 0u, 0u, 0u};
#pragma unroll
        for (int tt = 0; tt < 16; ++tt) {
            if (tt >= ntok) continue;
            const int t = t0 + tt;
            const bool h2 = (tt + 1 < ntok) && (t + 2 < seq_hi);
            const float r_n2 = h2 ? prr[(size_t)(t + 2) * 1792] : 0.f, k_n2 = h2 ? prr[(size_t)(t + 2) * 1792 + 512] : 0.f, v_n2 = h2 ? prr[(size_t)(t + 2) * 1792 + 1024] : 0.f;
            const unsigned short pq_c = pq_n, pk_c = pk_n, pv_c = pv_n;
            if (tt + 1 < ntok) { pq_n = p.pa[(size_t)(t + 1) * 1536 + c]; pk_n = p.pa[(size_t)(t + 1) * 1536 + 512 + c]; pv_n = p.pa[(size_t)(t + 1) * 1536 + 1024 + c]; }
            const float rs = r_cur + mu_r * (0.5f * (r_prev + r_nx) - r_cur);
            const float ks = k_cur + mu_k * (0.5f * (k_prev + k_nx) - k_cur);
            const float vs = v_cur + mu_v * (0.5f * (v_prev + v_nx) - v_cur);
            r_prev = r_cur; r_cur = r_nx; r_nx = r_n2; k_prev = k_cur; k_cur = k_nx; k_nx = k_n2; v_prev = v_cur; v_cur = v_nx; v_nx = v_n2;
            float kkv = ks * kkc;
            float z = -(w0f + dwf[tt]); float sp = fmaxf(z, 0.f) + __logf(1.0f + __expf(-fabsf(z)));
            const float decf = __expf(-__expf(-sp - 0.5f));
            const float aF = __builtin_amdgcn_rcpf(1.0f + __expf(-(a0f + af[tt])));
            const float kdf = ks * (1.0f + (aF - 1.0f) * kac);
            z = -(w0b + dwb[tt]); sp = fmaxf(z, 0.f) + __logf(1.0f + __expf(-fabsf(z)));
            const float decb = __expf(-__expf(-sp - 0.5f));
            const float aB = __builtin_amdgcn_rcpf(1.0f + __expf(-(a0b + ab[tt])));
            const float kdb = ks * (1.0f + (aB - 1.0f) * kac);
            bf16_t* par = p.pa + (size_t)t * 1536;
            const float q = bf2f(pq_c), kx = bf2f(pk_c);
            const float rz = red4(kkv * kkv, rs * (kdf + kdb) * uc, q * q, kx * kx);
            const float n2 = __builtin_bit_cast(float, __builtin_amdgcn_readlane(__builtin_bit_cast(int, rz), 0));
            const float bsum = __builtin_bit_cast(float, __builtin_amdgcn_readlane(__builtin_bit_cast(int, rz), 16));
            const float qs = __builtin_bit_cast(float, __builtin_amdgcn_readlane(__builtin_bit_cast(int, rz), 32));
            const float kss = __builtin_bit_cast(float, __builtin_amdgcn_readlane(__builtin_bit_cast(int, rz), 48));
            kkv *= rsqrtf(fmaxf(n2, 1e-24f));
            const size_t sb = ((size_t)t * 8 + wid) * 192 + lane;
            {
                const size_t th = (size_t)t * 8 + wid, thb = th + (size_t)MT * 8;
                p.shh[th * 192 + lane] = f2h(rs); p.shh[th * 192 + 64 + lane] = f2h(kkv); p.shh[th * 192 + 128 + lane] = f2h(vs);
                p.dw[th * 64 + lane] = decf; p.dw[thb * 64 + lane] = decb;
                p.dkb[th * 128 + lane] = f2h(kdf); p.dkb[th * 128 + 64 + lane] = f2h(kkv * aF);
                p.dkb[thb * 128 + lane] = f2h(kdb); p.dkb[thb * 128 + 64 + lane] = f2h(kkv * aB);
            }
            p.g[(size_t)t * 512 + c] = gg[tt];
            if (lane == 0) p.bon[(size_t)t * 8 + wid] = bsum;
            par[c] = f2bf(q * rsqrtf(qs * (1.0f / 64.0f) + 1e-6f) * qgn);
            par[512 + c] = f2bf(kx * rsqrtf(kss * (1.0f / 64.0f) + 1e-6f) * kgn);
            const unsigned vb16 = pv_c;
            if (tt & 1) vtp[tt >> 1] |= vb16 << 16; else vtp[tt >> 1] = vb16;
        }
        if (ntok == 16) { u32x4 w0 = {vtp[0], vtp[1], vtp[2], vtp[3]}, w1 = {vtp[4], vtp[5], vtp[6], vtp[7]};
            *(u32x4*)(p.vT + (size_t)c * MT + t0) = w0; *(u32x4*)(p.vT + (size_t)c * MT + t0 + 8) = w1; }
        else { u32x2 w0 = {vtp[0], vtp[1]}; *(u32x2*)(p.vT + (size_t)c * MT + t0) = w0; }
    }
}

__device__ __forceinline__ void phase_attn(const Params& p, int l, float* ldsf, bool emit_ctx, const int tid, const int bid) {
    const int wid = tid >> 6, lane = tid & 63, fr = lane & 15, fq = lane >> 4, qg = wid & 3, rsel = wid >> 2;
    unsigned char* ldsb = (unsigned char*)ldsf;
    constexpr int KC_OFF = 2048, VC_OFF = 2048 + 256 * 144, KL_OFF = VC_OFF + 64 * 528;
    static_assert(KL_OFF + 576 * 144 <= LDS_MAIN, "attention staging exceeds LDS");
    const int kc0 = qg == 0 ? 0 : (qg == 1 ? 8 : (qg == 2 ? 24 : 32));
    const int cq = qg * 16 + fr, cs = min(max(cq - 8, 0), 48);
    const int keyA = (fr >> 2) * 8 + (fr & 3);
    float gq = 0.f, gk = 0.f;
    for (int i = 0; i < 64; ++i) { gq = fmaxf(gq, fabsf(p.q_gain[l * 64 + i])); gk = fmaxf(gk, fabsf(p.k_gain[l * 64 + i])); }
    struct KV { bf16x8 a0[2], a1[2]; u32x4 v[4]; };
    for (int bb = bid; bb < 256; bb += gridDim.x) {
        const int bh = bb >> 3, b = bh >> 3, h = bh & 7, sub = bb & 7;
        __syncthreads();
        float bm = 0.f;
        for (int i = tid; i < 465; i += NTH) { const float v = p.na_bias[((size_t)l * 8 + h) * 465 + i]; ldsf[i] = v; bm = fmaxf(bm, fabsf(v)); }
        bm = wave_max(bm);
        if (lane == 0) ldsf[480 + wid] = bm;
#pragma unroll
        for (int i = 0; i < 4; ++i) {
            const int idx = tid + NTH * i;
            { const int key = idx >> 3, part = idx & 7;
              *(u32x4*)(ldsb + KC_OFF + key * 144 + part * 16) = *(const u32x4*)(p.pa + (size_t)(MLAT + b * 256 + key) * 1536 + 512 + h * 64 + part * 8); }
            { const int d = idx >> 5, part = idx & 31;
              *(u32x4*)(ldsb + VC_OFF + d * 528 + part * 16) = *(const u32x4*)(p.vT + (size_t)(h * 64 + d) * MT + MLAT + b * 256 + part * 8); }
        }
        __syncthreads();
        bm = 0.f;
#pragma unroll
        for (int i = 0; i < 8; ++i) bm = fmaxf(bm, ldsf[480 + i]);
        const float Mb = 8.0f * gq * gk * 1.02f + bm;
        const int nit = 4 + (emit_ctx ? 1 : 0);
        for (int n = 0; n < nit; ++n) {
            const bool isctx = n == 4;
            if (isctx && qg != 0) continue;
            const int rowbase = min(max(2 * (sub * 4 + n) - 4, 0), 56);
            if (!isctx) {
                __syncthreads();
#pragma unroll
                for (int i = 0; i < 9; ++i) { const int idx = tid + NTH * i, key = idx >> 3, part = idx & 7, krow = rowbase + (key >> 6);
                    if (krow < 64) *(u32x4*)(ldsb + KL_OFF + key * 144 + part * 16) = *(const u32x4*)(p.pa + (size_t)(b * 4096 + krow * 64 + (key & 63)) * 1536 + 512 + h * 64 + part * 8); }
                __syncthreads();
            }
            const int i_row = isctx ? 0 : 2 * (sub * 4 + n) + rsel;
            const int qbase = isctx ? MLAT + b * 256 + (sub * 2 + rsel) * 16 : b * 4096 + i_row * 64 + qg * 16;
            bf16x8 qf[2];
#pragma unroll
            for (int ks = 0; ks < 2; ++ks) qf[ks] = *(const bf16x8*)(p.pa + (size_t)(qbase + fr) * 1536 + h * 64 + ks * 32 + fq * 8);
            f32x4 oacc[4];
#pragma unroll
            for (int dt = 0; dt < 4; ++dt) oacc[dt] = (f32x4){0.f, 0.f, 0.f, 0.f};
            float lsum = 0.f;
            const bf16_t* vbase = p.vT + (size_t)(h * 64 + fr) * MT + fq * 8;
            const int start = min(max(i_row - 4, 0), 56);
            auto load_kv = [&](int s, KV& kv) {
                const int ktok0 = b * 4096 + (start + s) * 64 + kc0;
                const int kl0 = (start + s - rowbase) * 64 + kc0 + keyA;
#pragma unroll
                for (int ks = 0; ks < 2; ++ks) { kv.a0[ks] = *(const bf16x8*)(ldsb + KL_OFF + kl0 * 144 + (ks * 32 + fq * 8) * 2); kv.a1[ks] = *(const bf16x8*)(ldsb + KL_OFF + (kl0 + 4) * 144 + (ks * 32 + fq * 8) * 2); }
#pragma unroll
                for (int dt = 0; dt < 4; ++dt) kv.v[dt] = *(const u32x4*)(vbase + (size_t)(dt * 16) * MT + ktok0);
            };
            auto load_kv_ctx = [&](int u, KV& kv) {
#pragma unroll
                for (int ks = 0; ks < 2; ++ks) { kv.a0[ks] = *(const bf16x8*)(ldsb + KC_OFF + (u * 32 + keyA) * 144 + (ks * 32 + fq * 8) * 2); kv.a1[ks] = *(const bf16x8*)(ldsb + KC_OFF + (u * 32 + keyA + 4) * 144 + (ks * 32 + fq * 8) * 2); }
#pragma unroll
                for (int dt = 0; dt < 4; ++dt) kv.v[dt] = *(const u32x4*)(ldsb + VC_OFF + (dt * 16 + fr) * 528 + (u * 32 + fq * 8) * 2);
            };
            auto compute = [&](int s, bool local, const KV& kv) {
                f32x4 s0 = {0.f, 0.f, 0.f, 0.f}, s1 = {0.f, 0.f, 0.f, 0.f};
#pragma unroll
                for (int ks = 0; ks < 2; ++ks) { s0 = __builtin_amdgcn_mfma_f32_16x16x32_bf16(kv.a0[ks], qf[ks], s0, 0, 0, 0); s1 = __builtin_amdgcn_mfma_f32_16x16x32_bf16(kv.a1[ks], qf[ks], s1, 0, 0, 0); }
                const float* bt = ldsf + (local ? (start + s - i_row + 7) * 31 : 0);
                float e[8];
#pragma unroll
                for (int j = 0; j < 4; ++j) {
                    const int kc = kc0 + fq * 8 + j, kc2 = kc + 4;
                    const int d0 = min(max(kc - cq + 15, 0), 30), d1 = min(max(kc2 - cq + 15, 0), 30);
                    const bool v0 = !local || (kc >= cs && kc < cs + 16), v1 = !local || (kc2 >= cs && kc2 < cs + 16);
                    const float b0v = local ? bt[d0] : 0.f, b1v = local ? bt[d1] : 0.f;
                    e[j] = v0 ? __expf(s0[j] + b0v - Mb) : 0.f;
                    e[4 + j] = v1 ? __expf(s1[j] + b1v - Mb) : 0.f;
                    lsum += e[j] + e[4 + j];
                }
                u32x4 pw; pw.x = cvt_pk_bf16(e[0], e[1]); pw.y = cvt_pk_bf16(e[2], e[3]); pw.z = cvt_pk_bf16(e[4], e[5]); pw.w = cvt_pk_bf16(e[6], e[7]);
                const bf16x8 pf = __builtin_bit_cast(bf16x8, pw);
#pragma unroll
                for (int dt = 0; dt < 4; ++dt) oacc[dt] = __builtin_amdgcn_mfma_f32_16x16x32_bf16(pf, __builtin_bit_cast(bf16x8, kv.v[dt]), oacc[dt], 0, 0, 0);
            };
            KV ka, kb;
            if (!isctx) {
                load_kv(0, ka);
                for (int s = 0; s < 8; s += 2) {
                    load_kv(s + 1, kb);
                    compute(s, true, ka);
                    if (s + 2 < 8) load_kv(s + 2, ka);
                    compute(s + 1, true, kb);
                }
            }
            load_kv_ctx(0, ka);
            for (int u = 0; u < 8; u += 2) {
                load_kv_ctx(u + 1, kb);
                compute(u, false, ka);
                if (u + 2 < 8) load_kv_ctx(u + 2, ka);
                compute(u + 1, false, kb);
            }
            lsum = swapadd16(lsum, lsum); lsum = swapadd32(lsum, lsum);
#pragma unroll
            for (int j = 0; j < 4; ++j) {
                const float lq = __builtin_bit_cast(float, __builtin_amdgcn_ds_bpermute((fq * 4 + j) * 4, __builtin_bit_cast(int, lsum)));
                const float inv = 1.0f / lq;
                bf16_t* orow = p.h + (size_t)(qbase + fq * 4 + j) * DM + h * 64 + fr;
#pragma unroll
                for (int dt = 0; dt < 4; ++dt) orow[dt * 16] = f2bf(oacc[dt][j] * inv);
            }
        }
    }
}

__device__ __forceinline__ int scan_tok(int s, int b, int dir) { return s < 256 ? MLAT + b * 256 + (dir ? 255 - s : s) : b * 4096 + (dir ? 4095 - (s - 256) : (s - 256)); }
__device__ __forceinline__ void phase_scan(const Params& p, int l, float* ldsf, const int tid, const int bid) {
    const int wid = tid >> 6, lane = tid & 63;
    constexpr int CH = 32, NSTEP = 4352, NCHUNK = NSTEP / CH, NLD = 7;
    float* outb = ldsf + 2 * CH * 384;
#define SCAN_BAR() asm volatile("s_waitcnt lgkmcnt(0)\n\ts_barrier" ::: "memory")
#define SCAN_ISSUE(REG, chunk) do { _Pragma("unroll") for (int i = 0; i < NLD; ++i) { \
        const int idx = lt + 256 * i; \
        if (i < 2) { const int st = idx >> 4, part = idx & 15; const size_t th = (size_t)scan_tok((chunk) * CH + st, b, dir) * 8 + h; \
            REG[i] = *(const u32x4*)(dwp + th * 64 + part * 4); } \
        else { const int j = idx - 512, st = j / 40, r = j - st * 40, vq = r >> 3, part = r & 7; const size_t th = (size_t)scan_tok((chunk) * CH + st, b, dir) * 8 + h; \
            const bf16_t* src = vq < 3 ? p.shh + th * 192 + vq * 64 : dkp + th * 128 + (vq - 3) * 64; \
            REG[i] = *(const u32x4*)(src + part * 8); } } } while (0)
#define SCAN_WRITE(REG, chunk) do { float* dstb = ldsf + ((chunk) & 1) * (CH * 384); _Pragma("unroll") for (int i = 0; i < NLD; ++i) { \
        const int idx = lt + 256 * i; \
        if (i < 2) { const int st = idx >> 4, part = idx & 15; *(u32x4*)(dstb + st * 384 + 64 + part * 4) = REG[i]; } \
        else { const int j = idx - 512, st = j / 40, r = j - st * 40, vq = r >> 3, part = r & 7; \
            const int lv = vq == 0 ? 3 : (vq == 1 ? 0 : (vq == 2 ? 5 : (vq == 3 ? 2 : 4)));        \
            float* d = dstb + st * 384 + lv * 64 + part * 8; const u32x4 q = REG[i]; \
            f32x4 lo, hi; \
            lo[0] = h2f((bf16_t)(q.x & 0xffffu)); lo[1] = h2f((bf16_t)(q.x >> 16)); lo[2] = h2f((bf16_t)(q.y & 0xffffu)); lo[3] = h2f((bf16_t)(q.y >> 16)); \
            hi[0] = h2f((bf16_t)(q.z & 0xffffu)); hi[1] = h2f((bf16_t)(q.z >> 16)); hi[2] = h2f((bf16_t)(q.w & 0xffffu)); hi[3] = h2f((bf16_t)(q.w >> 16)); \
            if (vq == 4) { lo = -lo; hi = -hi; }        \
            *(f32x4*)d = lo; *(f32x4*)(d + 4) = hi; } } } while (0)
#define SCAN_LOADER(REG, c) do { \
        if ((c) + 1 < NCHUNK) SCAN_WRITE(REG, (c) + 1); \
        if ((c) + 3 < NCHUNK) SCAN_ISSUE(REG, (c) + 3); \
        if ((c) >= 1 && lt < CH * 4) { const int st = lt >> 2, part = lt & 3; const int s = ((c) - 1) * CH + st - 1; \
            if (s >= 0) { const float* ob_ = outb + (((c) - 1) & 1) * (CH * 64) + st * 64 + part * 16; f32x4 o4; \
                _Pragma("unroll") for (int e = 0; e < 4; ++e) { const f32x4 q4 = *(const f32x4*)(ob_ + e * 4); o4[e] = (q4[0] + q4[1]) + (q4[2] + q4[3]); } \
                *(f32x4*)(op + (size_t)scan_tok(s, b, dir) * 512 + part * 4) = o4; } } } while (0)
    for (int unit = bid; unit < 256; unit += gridDim.x) {
        const int chain = (unit >> 5) * 8 + (unit & 7), quarter = (unit >> 3) & 3;
        const int dir = chain >> 5, b = (chain >> 3) & 3, h = chain & 7;
        const float* dwp = p.dw + (size_t)dir * MT * 8 * 64; const bf16_t* dkp = p.dkb + (size_t)dir * MT * 8 * 128;
        float* op = p.o + (size_t)dir * MT * 512 + h * 64 + quarter * 16;
        const int lt = tid - 256;
        u32x4 RA[NLD], RB[NLD];
        __syncthreads();
        if (wid >= 4) { SCAN_ISSUE(RA, 0); SCAN_WRITE(RA, 0); SCAN_ISSUE(RA, 1); SCAN_ISSUE(RB, 2); }
        SCAN_BAR();
        f32x4 S4 = {0.f, 0.f, 0.f, 0.f};
        const int j0 = wid * 4, g = lane >> 4, kl = lane & 15;
        f32x4 rvp = {0.f, 0.f, 0.f, 0.f};
        auto compute_chunk = [&](int c) {
            const float* bufc = ldsf + (c & 1) * (CH * 384) + kl * 4;
            const float* bufv = ldsf + (c & 1) * (CH * 384) + 320 + quarter * 16 + j0 + g;
            float* ob = outb + (c & 1) * (CH * 64) + (j0 + g) * 4 + (kl >> 2);
            f32x4 n_kk = *(const f32x4*)(bufc), n_w = *(const f32x4*)(bufc + 64), n_kv = *(const f32x4*)(bufc + 128), n_rv = *(const f32x4*)(bufc + 192), n_bb = *(const f32x4*)(bufc + 256);
            float n_v = bufv[0];
#pragma unroll
            for (int st = 0; st < CH; ++st) {
                const f32x4 kk = n_kk, w = n_w, kv = n_kv, rv = n_rv, bb = n_bb;
                const float v = n_v;
                if (st + 1 < CH) {
                    const float* bs = bufc + (st + 1) * 384;
                    n_kk = *(const f32x4*)(bs); n_w = *(const f32x4*)(bs + 64); n_kv = *(const f32x4*)(bs + 128); n_rv = *(const f32x4*)(bs + 192); n_bb = *(const f32x4*)(bs + 256);
                    n_v = bufv[(st + 1) * 384];
                }
                const f32x2 Slo = {S4[0], S4[1]}, Shi = {S4[2], S4[3]};
                f32x2 pa = Slo * (f32x2){kk[0], kk[1]}; pa = Shi * (f32x2){kk[2], kk[3]} + pa;
                f32x2 qa = Slo * (f32x2){rvp[0], rvp[1]}; qa = Shi * (f32x2){rvp[2], rvp[3]} + qa;
                float z = pa[0] + pa[1], zo = qa[0] + qa[1];
                const f32x4 T4 = S4 * w + kv * v;
                z += dppf<0xB1>(z); zo += dppf<0xB1>(zo);
                z += dppf<0x4E>(z); zo += dppf<0x4E>(zo);
                z += dppf<0x124>(z);
                z += dppf<0x128>(z);
                S4 = bb * z + T4;
                ob[st * 64] = zo;
                rvp = rv;
            }
        };
        for (int c = 0; c < NCHUNK; c += 2) {
            if (wid >= 4) SCAN_LOADER(RA, c); else compute_chunk(c);
            SCAN_BAR();
            if (wid >= 4) SCAN_LOADER(RB, c + 1); else compute_chunk(c + 1);
            SCAN_BAR();
        }
        if (wid >= 4) {
            if (lt < CH * 4) { const int st = lt >> 2, part = lt & 3; const int s = (NCHUNK - 1) * CH + st - 1;
                const float* ob_ = outb + ((NCHUNK - 1) & 1) * (CH * 64) + st * 64 + part * 16; f32x4 o4;
#pragma unroll
                for (int e = 0; e < 4; ++e) { const f32x4 q4 = *(const f32x4*)(ob_ + e * 4); o4[e] = (q4[0] + q4[1]) + (q4[2] + q4[3]); }
                *(f32x4*)(op + (size_t)scan_tok(s, b, dir) * 512 + part * 4) = o4; }
        } else {
            const f32x4 qk = S4 * rvp;
            float zo = (qk[0] + qk[1]) + (qk[2] + qk[3]);
            zo += dppf<0xB1>(zo); zo += dppf<0x4E>(zo); zo += dppf<0x124>(zo); zo += dppf<0x128>(zo);
            if (kl == 0) op[(size_t)scan_tok(NSTEP - 1, b, dir) * 512 + j0 + g] = zo;
        }
    }
#undef SCAN_BAR
#undef SCAN_ISSUE
#undef SCAN_WRITE
#undef SCAN_LOADER
}

__device__ __forceinline__ void phase_readout(const Params& p, int l, const int tid, const int bid) {
    const int wid = tid >> 6, lane = tid & 63, c = tid;
    const float lg = p.lnx_gain[l * 512 + c], lb = p.lnx_bias[l * 512 + c];
    const float* of = p.o; const float* ob = p.o + (size_t)MT * 512;
    for (int tb = bid; tb < MT; tb += 4 * gridDim.x) {
        float o[4], bn[4], vv[4], gg[4];
#pragma unroll
        for (int j = 0; j < 4; ++j) { const int t = tb + j * gridDim.x; const bool ok = t < MT; const size_t tt = ok ? t : 0;
            o[j] = of[tt * 512 + c] + ob[tt * 512 + c]; bn[j] = p.bon[tt * 8 + wid]; vv[j] = h2f(p.shh[(tt * 8 + wid) * 192 + 128 + lane]); gg[j] = p.g[tt * 512 + c]; }
#pragma unroll
        for (int j = 0; j < 4; ++j) { const int t = tb + j * gridDim.x;
            const float mean = wave_sum(o[j]) * (1.0f / 64.0f);
            const float d = o[j] - mean;
            const float var = wave_sum(d * d) * (1.0f / 64.0f);
            float y = d * rsqrtf(var + 64e-5f) * lg + lb;
            y += bn[j] * vv[j];
            y *= gg[j];
            if (t < MT) p.h[(size_t)t * DM + 512 + c] = f2bf(y); }
    }
}

__global__ void __launch_bounds__(NTH, 2) mega(Params p) {
    extern __shared__ __attribute__((aligned(16))) unsigned char shm[];
    cg::grid_group grid = cg::this_grid();
    float* ldsf = (float*)shm;
    LAS unsigned char* ldsg = (LAS unsigned char*)shm;
    volatile LAS unsigned* xbst = (volatile LAS unsigned*)(ldsg + LDS_MAIN);
    if (threadIdx.x == 0) { xbst[0] = 0u; xbst[1] = 0u; }
    __syncthreads();
    const XcdBarrier xb = xcd_barrier_post(p.bar, xbst);
    const int wave_s = __builtin_amdgcn_readfirstlane(threadIdx.x >> 6);
    for (int ph = p.lo; ph < p.hi; ++ph) {
        int tid, bid = blockIdx.x;
        asm volatile("v_mbcnt_lo_u32_b32 %0, -1, 0\n\tv_mbcnt_hi_u32_b32 %0, -1, %0" : "=v"(tid));
        tid += wave_s * 64;
        asm volatile("" : "+v"(tid), "+s"(bid));
        if (ph == 0) {
            phase_init(p, ldsf, tid, bid);
        } else {
            const int l = (ph - 1) / 12, k = (ph - 1) % 12;
            pg8::StaticOrder S;
            const bool last = l == NLAYER - 1;
            const float* mods_l = p.mods + (size_t)l * 5 * 9216;
            switch (k) {
                case 0: phase_convert(p, l, ldsf, tid, bid);
                        phase_norm(p, l, 0, tid, bid, l > 0 ? 4 : 0, p.mods + ((size_t)(l > 0 ? l - 1 : 0) * 5 + 4) * 9216 + 8 * 1024, 0.5f, l == 0 ? p.x : p.out, l == 0 ? p.ctx : p.xc); break;
                case 1: case 10: { const int M = (k == 10 && last) ? MLAT : MT; pg8::Gemm g{p.h, p.wb + (k == 1 ? WB_UP0 : WB_UP1), M, 5632, DM}; S.init(M, 5632, DM, gridDim.x, bid, 0); EpiSwiglu E{p.act}; pg8::gemm_phase(ldsg, g, S, E, tid); } break;
                case 2: case 11: { pg8::Gemm g{p.act, p.wb + (k == 2 ? WB_DN0 : WB_DN1), MT, DM, DFF}; S.init(MLAT, DM, DFF, gridDim.x, bid, (k == 11 && last) ? 0 : 4); EpiResid E{p.out, p.xc, mods_l, k == 2 ? 2 : 8, 0.5f, p.part, (l == 0 && k == 2) ? p.x : p.out}; pg8::gemm_phase<EpiResid, false, true>(ldsg, g, S, E, tid); } break;
                case 3: phase_norm(p, l, 1, tid, bid, 4, mods_l + 4 * 9216 + 2 * 1024, 0.5f, p.out, l == 0 ? p.ctx : p.xc); break;
                case 4: { pg8::Gemm g{p.h, p.wb + WB_WIN, MT, DIN, DM}; S.init(MT, DIN, DM, gridDim.x, bid, 0); EpiWin E{p.pa, p.pr}; pg8::gemm_phase(ldsg, g, S, E, tid); } break;
                case 5: phase_prep(p, l, ldsf, tid, bid); break;
                case 6: phase_attn(p, l, ldsf, !last, tid, bid); phase_scan(p, l, ldsf, tid, bid); break;
                case 7: phase_readout(p, l, tid, bid); break;
                case 8: { pg8::Gemm g{p.h, p.wb + WB_WOUT, MT, DM, DM}; S.init(MLAT, DM, DM, gridDim.x, bid, last ? 0 : 2); EpiResid E{p.out, p.xc, mods_l, 5, 1.0f, p.part, p.out}; pg8::gemm_phase<EpiResid, false, true>(ldsg, g, S, E, tid); } break;
                case 9: phase_norm(p, l, 2, tid, bid, last ? 0 : 2, mods_l + 4 * 9216 + 5 * 1024, 1.0f, p.out, p.xc); break;
            }
        }
        if (ph + 1 < p.hi) { if (p.hi < 0) grid.sync(); xcd_barrier(xb, tid); }
    }
}

extern "C" void kernel_launch(void* const* d_in, const int* in_sizes, int n_in, void* d_out, int out_size, void* d_ws, size_t ws_size, hipStream_t stream) {
    static int grid_blocks = 0;
    if (!grid_blocks) {
        int dev = 0, cus = 0, per_cu = 0;
        hipGetDevice(&dev);
        hipDeviceGetAttribute(&cus, hipDeviceAttributeMultiprocessorCount, dev);
        hipFuncSetAttribute((const void*)mega, hipFuncAttributeMaxDynamicSharedMemorySize, LDS_BYTES);
        hipOccupancyMaxActiveBlocksPerMultiprocessor(&per_cu, mega, NTH, LDS_BYTES);
        grid_blocks = cus * per_cu;
        if (grid_blocks > 256) grid_blocks = 256;
        if (grid_blocks < 1) grid_blocks = 1;
    }
    Params p{};
    const float** pp = (const float**)&p;
    for (int i = 0; i < 25; ++i) pp[i] = (const float*)d_in[i];
    p.out = (float*)d_out;
    char* ws = (char*)d_ws; size_t off = 0;
    auto take = [&](size_t bytes) { char* r = ws + off; off += (bytes + 255) & ~(size_t)255; return r; };
    p.wb = (bf16_t*)take(WB_ELEMS * 2);
    p.xc = (float*)take((size_t)MCTX * DM * 4);
    p.mods = (float*)take((size_t)NLAYER * 5 * 9216 * 4);
    p.h = (bf16_t*)take((size_t)MT * DM * 2);
    p.pa = (bf16_t*)take((size_t)MT * 1536 * 2);
    p.pr = (float*)take((size_t)MT * 1792 * 4);
    p.act = p.pa;
    p.o = p.pr;
    p.vT = (bf16_t*)take((size_t)512 * MT * 2);
    p.shh = (bf16_t*)take((size_t)MT * 8 * 192 * 2);
    p.dw = (float*)take((size_t)2 * MT * 8 * 64 * 4);
    p.dkb = (bf16_t*)take((size_t)2 * MT * 8 * 128 * 2);
    p.g = (float*)take((size_t)MT * 512 * 4);
    p.bon = (float*)take((size_t)MT * 8 * 4);
    p.part = (float*)take((size_t)4 * MCTX * DM * 4);
    p.lw = (bf16_t*)take((size_t)196608 * 2);
    p.bar = (unsigned*)take((size_t)XCD_BAR_WORDS * 4);
    (void)hipMemsetAsync(p.bar, 0, (size_t)XCD_BAR_WORDS * 4, stream);
    p.lo = 0; p.hi = 1 + 12 * NLAYER;
    void* args[] = {&p};
    hipError_t e = hipLaunchCooperativeKernel((const void*)mega, dim3(grid_blocks), dim3(NTH), args, LDS_BYTES, stream);
    if (e != hipSuccess) fprintf(stderr, "cooperative launch failed: %s (grid %d)\n", hipGetErrorString(e), grid_blocks);
}
```

```cpp
#include <hip/hip_runtime.h>
#include <hip/hip_cooperative_groups.h>
#include <cstdio>
namespace cg = cooperative_groups;

#define LAS __attribute__((address_space(3)))
typedef unsigned short bf16_t;
typedef short bf16x8 __attribute__((ext_vector_type(8)));
typedef short bf16x4 __attribute__((ext_vector_type(4)));
typedef float f32x4 __attribute__((ext_vector_type(4)));
typedef float f32x2 __attribute__((ext_vector_type(2)));
typedef unsigned u32x4 __attribute__((ext_vector_type(4)));
typedef unsigned u32x2 __attribute__((ext_vector_type(2)));

constexpr int DM = 1024, MLAT = 16384, MCTX = 1024, MT = 17408, DFF = 2816, DIN = 3328, NLAYER = 4;
constexpr int NTH = 512;
constexpr int LDS_MAIN = 155648;
constexpr int LDS_BYTES = LDS_MAIN + 16;

struct Params {
    const float *x, *c, *ctx, *c_ctx, *w_mod, *b_mod, *norm_gain, *ffn_up, *ffn_down, *w_in, *q_gain, *k_gain, *na_bias, *shift_mu,
        *decay_w0, *decay_w2, *iclr_a0, *iclr_a2, *gate_g2, *key_k, *key_a, *bonus_u, *lnx_gain, *lnx_bias, *w_out;
    float* out;
    float* xc;
    float* mods;
    bf16_t* wb;
    bf16_t* h;
    bf16_t* pa;
    float* pr;
    bf16_t* act;
    float* o;
    bf16_t* vT;
    bf16_t* shh;
    float* dw;
    bf16_t* dkb;
    float* g;
    float* bon;
    float* part;
    bf16_t* lw;
    unsigned* bar;
    int lo, hi;
};

constexpr size_t WB_UP0 = 0, WB_UP1 = 5767168, WB_DN0 = 11534336, WB_DN1 = 14417920, WB_WIN = 17301504, WB_WOUT = 20709376, WB_ELEMS = 21757952;

__device__ __forceinline__ unsigned cvt_pk_bf16(float lo, float hi) { unsigned r; asm volatile("v_cvt_pk_bf16_f32 %0, %1, %2" : "=v"(r) : "v"(lo), "v"(hi)); return r; }
typedef _Float16 f16x8 __attribute__((ext_vector_type(8)));
__device__ __forceinline__ unsigned pk_f16(float lo, float hi) { const _Float16 a = (_Float16)lo, b = (_Float16)hi; return (unsigned)__builtin_bit_cast(unsigned short, a) | ((unsigned)__builtin_bit_cast(unsigned short, b) << 16); }
__device__ __forceinline__ bf16_t f2h(float x) { const _Float16 a = (_Float16)x; return __builtin_bit_cast(unsigned short, a); }
__device__ __forceinline__ float h2f(bf16_t b) { return (float)__builtin_bit_cast(_Float16, b); }
__device__ __forceinline__ bf16_t f2bf(float x) { return (bf16_t)(cvt_pk_bf16(x, 0.f) & 0xffffu); }
__device__ __forceinline__ float bf2f(bf16_t b) { return __uint_as_float(((unsigned)b) << 16); }
template <int CTRL> __device__ __forceinline__ float dppf(float x) { return __builtin_bit_cast(float, __builtin_amdgcn_update_dpp(0, __builtin_bit_cast(int, x), CTRL, 0xf, 0xf, true)); }
__device__ __forceinline__ float swapadd32(float a, float b) {
    asm("s_nop 1\n\tv_permlane32_swap_b32 %0, %1" : "+v"(a), "+v"(b));
    return a + b;
}
__device__ __forceinline__ float swapadd16(float a, float b) {
    asm("s_nop 1\n\tv_permlane16_swap_b32 %0, %1" : "+v"(a), "+v"(b));
    return a + b;
}
__device__ __forceinline__ float red4(float x0, float x1, float x2, float x3) {
    const float y0 = swapadd32(x0, x2), y1 = swapadd32(x1, x3);
    float z = swapadd16(y0, y1);
    z += dppf<0xB1>(z); z += dppf<0x4E>(z); z += dppf<0x124>(z); z += dppf<0x128>(z);
    return z;
}
__device__ __forceinline__ float wave_sum(float v) {
    v += dppf<0xB1>(v); v += dppf<0x4E>(v); v += dppf<0x124>(v); v += dppf<0x128>(v);
    v = swapadd16(v, v); v = swapadd32(v, v);
    return v;
}
__device__ __forceinline__ float wave_max(float v) {
    v = fmaxf(v, dppf<0xB1>(v)); v = fmaxf(v, dppf<0x4E>(v)); v = fmaxf(v, dppf<0x124>(v)); v = fmaxf(v, dppf<0x128>(v));
    { float a = v, b = v; asm("s_nop 1\n\tv_permlane16_swap_b32 %0, %1" : "+v"(a), "+v"(b)); v = fmaxf(a, b); }
    { float a = v, b = v; asm("s_nop 1\n\tv_permlane32_swap_b32 %0, %1" : "+v"(a), "+v"(b)); v = fmaxf(a, b); }
    return v;
}
__device__ __forceinline__ float sigmoidf_(float x) { return 1.0f / (1.0f + expf(-x)); }


#define XB_TMO      128
#define XB_XCNT(j)  (256  + 64 * (j))
#define XB_XSUB(j)  (1280 + 64 * (j))
#define XB_XGEN(j)  (2304 + 64 * (j))
#define XB_TOP      3328
#define XB_TOPGEN   3392
#define XCD_BAR_WORDS 3456
#define XB_SPIN_CAP (1u << 18)
__device__ __forceinline__ unsigned xb_ld(unsigned* p)              { return __hip_atomic_load(p, __ATOMIC_RELAXED, __HIP_MEMORY_SCOPE_AGENT); }
__device__ __forceinline__ unsigned xb_add(unsigned* p, unsigned v) { return __hip_atomic_fetch_add(p, v, __ATOMIC_RELAXED, __HIP_MEMORY_SCOPE_AGENT); }
__device__ __forceinline__ unsigned xb_xcc_id() { return (unsigned)__builtin_amdgcn_s_getreg((3 << 11) | 20) & 0xFu; }
#define XB_SPIN(cond, bar) do { unsigned _sp = 0; while (cond) { __builtin_amdgcn_s_sleep(0); \
    if ((++_sp & 255u) == 0u) { if (xb_ld(&(bar)[XB_TMO])) break; if (_sp > XB_SPIN_CAP) { atomicAdd(&(bar)[XB_TMO], 1u); break; } } } } while (0)
struct XcdBarrier { unsigned* bar; unsigned x; volatile LAS unsigned* st; };
__device__ __forceinline__ XcdBarrier xcd_barrier_post(unsigned* bar, volatile LAS unsigned* st) {
    XcdBarrier b; b.bar = bar; b.x = xb_xcc_id(); b.st = st;
    if (threadIdx.x == 0) (void)xb_add(&bar[XB_XCNT(b.x)], 1u);
    return b;
}
__device__ __forceinline__ void xcd_barrier_complete(unsigned* bar, unsigned x, unsigned& nloc, unsigned& nx) {
    const unsigned G = gridDim.x * gridDim.y * gridDim.z;
    unsigned sum, cnt, mine, sp = 0u;
    for (;;) {
        sum = 0u; cnt = 0u; mine = 0u;
#pragma unroll
        for (unsigned j = 0; j < 16; ++j) { const unsigned c = xb_ld(&bar[XB_XCNT(j)]); sum += c; cnt += (c > 0u) ? 1u : 0u; mine = (j == x) ? c : mine; }
        if (sum == G) break;
        __builtin_amdgcn_s_sleep(1);
        if ((++sp & 255u) == 0u) { if (xb_ld(&bar[XB_TMO])) break; if (sp > XB_SPIN_CAP) { atomicAdd(&bar[XB_TMO], 1u); break; } }
    }
    nloc = mine > 0u ? mine : 1u; nx = cnt > 0u ? cnt : 1u;
}
__device__ __forceinline__ void xcd_barrier(const XcdBarrier& b, const int tid) {
    asm volatile("s_waitcnt vmcnt(0)" ::: "memory");
    __syncthreads();
    if (tid == 0) {
        unsigned* bar = b.bar;
        __builtin_amdgcn_s_waitcnt(0);
        unsigned nloc = b.st[0], nx = b.st[1];
        if (nloc == 0u) { xcd_barrier_complete(bar, b.x, nloc, nx); b.st[0] = nloc; b.st[1] = nx; }
        const unsigned old = xb_add(&bar[XB_XSUB(b.x)], 1u);
        const unsigned gen = old / nloc;
        if (old + 1u == (gen + 1u) * nloc) {
            __builtin_amdgcn_fence(__ATOMIC_RELEASE, "agent");
            asm volatile("s_waitcnt vmcnt(0)" ::: "memory");
            const unsigned og = xb_add(&bar[XB_TOP], 1u);
            const unsigned tg = og / nx;
            if (og + 1u == (tg + 1u) * nx) xb_add(&bar[XB_TOPGEN], 1u);
            else XB_SPIN(xb_ld(&bar[XB_TOPGEN]) == tg, bar);
            __builtin_amdgcn_fence(__ATOMIC_ACQUIRE, "agent");
            xb_add(&bar[XB_XGEN(b.x)], 1u);
            asm volatile("s_waitcnt vmcnt(0)" ::: "memory");
        } else {
            XB_SPIN(xb_ld(&bar[XB_XGEN(b.x)]) == gen, bar);
            __builtin_amdgcn_fence(__ATOMIC_ACQUIRE, "agent");
            asm volatile("s_waitcnt vmcnt(0)" ::: "memory");
        }
    }
    __syncthreads();
}

namespace pg8 {
constexpr int BM = 256, BK = 64, HALF = 128, HTB = HALF * BK * 2, STAGE_BYTES = 8 * HTB, NXCD = 8, WGM = 8;
__host__ __device__ __forceinline__ int lds_byte(int r, int c) { const int st = (r >> 4) * 2 + (c >> 5), rr = r & 15, cc = c & 31, ob = rr * 64 + cc * 2; return st * 1024 + (ob ^ (((ob >> 9) & 1) << 5)); }
__host__ __device__ __forceinline__ void stage_rc(int b, int& R, int& C) { const int st = b / 1024, sb = b % 1024, swz = sb ^ (((sb >> 9) & 1) << 5); R = (st >> 1) * 16 + swz / 64; C = (st & 1) * 32 + (swz % 64) / 2; }
__host__ __device__ __forceinline__ int perm32(int rho) { const int n = rho >> 4, i = rho & 15; return 8 * (i >> 2) + 4 * n + (i & 3); }
struct Unit { int pm, pn, kofs, nt, split; };
struct Gemm { const bf16_t* A; const bf16_t* Bt; int M, N, K; };
struct StaticOrder {
    int nM, nN, nwg, G, c, ntk, nsl;
    __device__ void init(int M, int N, int K, int G_, int c_, int nsl_) { nM = M / BM; nN = N / BM; nwg = nM * nN; G = G_; c = c_; ntk = K / BK; nsl = nsl_; }
    __device__ bool next(int i, Unit& u) const {
        const long L = (long)i * G + c;
        if (L >= nwg) {
            const int s = (int)(L - nwg); if (s >= 16 * nsl) return false;
            const int cu = s / nsl, sl = s - cu * nsl, np = ntk >> 1, q = np / nsl, r = np - q * nsl;
            u.pm = 64 + (cu >> 2); u.pn = cu & 3; u.kofs = (sl * q + (sl < r ? sl : r)) * 128; u.nt = 2 * (q + (sl < r ? 1 : 0)); u.split = sl + 1; return true;
        }
        int wgid = (int)L; { const int q = nwg / NXCD, r = nwg % NXCD, xcd = wgid % NXCD, off = wgid / NXCD; wgid = (xcd < r ? xcd * (q + 1) : r * (q + 1) + (xcd - r) * q) + off; }
        const int nig = WGM * nN, gid = wgid / nig, fm = gid * WGM, gsz = (nM - fm) < WGM ? (nM - fm) : WGM;
        u.pm = fm + ((wgid % nig) % gsz); u.pn = (wgid % nig) / gsz; u.kofs = 0; u.nt = ntk; u.split = 0; return true;
    }
};

template <class Epi, bool ALIGN_EPI = true, bool SP2 = true>
__device__ __forceinline__ void gemm_phase(LAS unsigned char* lds, const Gemm g, const StaticOrder& S, const Epi& E, const int tid) {
    const int wid = __builtin_amdgcn_readfirstlane(tid >> 6), lane = tid & 63, wr = wid >> 2, wc = wid & 3, fr = lane & 15, fq = lane >> 4;
    const int K = g.K;
    unsigned voffA[2], voffB[2];
#pragma unroll
    for (int i = 0; i < 2; ++i) { int R, C; stage_rc(tid * 16 + i * 8192, R, C); const int Rb = Epi::PERM ? ((R & ~31) + perm32(R & 31)) : R;
        voffA[i] = (unsigned)(R * K + C) * 2u; voffB[i] = (unsigned)(Rb * K + C) * 2u; }
    const size_t kstep = (size_t)(BK * 2);
    const size_t hstep = (size_t)HALF * K * 2;
    const size_t tstep = 2 * hstep;
    const unsigned ldsw = (unsigned)wid * 1024u;
    const int aoff = lds_byte(wr * 64 + fr, fq * 8), boff = lds_byte(wc * 32 + fr, fq * 8);
#define PG8_SA(b, h) (((b) * 2 + (h)) * HTB)
#define PG8_SB(b, h) ((4 + (b) * 2 + (h)) * HTB)
#define PG8_STAGE(bufoff, gbase, voff) do { _Pragma("unroll") for (int _i = 0; _i < 2; ++_i) \
        __builtin_amdgcn_global_load_lds((const unsigned*)((const char*)(gbase) + (voff)[_i]), (LAS unsigned*)(lds + (bufoff) + ldsw + _i * 8192), 16, 0, 0); } while (0)
#define PG8_LDA(dst, b, h) do { _Pragma("unroll") for (int m = 0; m < 4; ++m) _Pragma("unroll") for (int k = 0; k < 2; ++k) dst[m][k] = *(const LAS bf16x8*)(lds + PG8_SA(b, h) + aoff + m * 2048 + k * 1024); } while (0)
#define PG8_LDB(dst, b, h) do { _Pragma("unroll") for (int n = 0; n < 2; ++n) _Pragma("unroll") for (int k = 0; k < 2; ++k) dst[n][k] = *(const LAS bf16x8*)(lds + PG8_SB(b, h) + boff + n * 2048 + k * 1024); } while (0)
#define PG8_MMA(ai, bj, At, Bt) do { __builtin_amdgcn_s_setprio(1); _Pragma("unroll") for (int m = 0; m < 4; ++m) _Pragma("unroll") for (int n = 0; n < 2; ++n) _Pragma("unroll") for (int k = 0; k < 2; ++k) \
        acc[ai][bj][m][n] = __builtin_amdgcn_mfma_f32_16x16x32_bf16(Bt[n][k], At[m][k], acc[ai][bj][m][n], 0, 0, 0); __builtin_amdgcn_s_setprio(0); } while (0)
#define PG8_WAIT_V(n) asm volatile("s_waitcnt vmcnt(" #n ")" ::: "memory")
#define PG8_WAIT_L(n) asm volatile("s_waitcnt lgkmcnt(" #n ")" ::: "memory")
#define PG8_BAR __builtin_amdgcn_s_barrier()
#define PG8_SCHED __builtin_amdgcn_sched_barrier(0)
    Unit cur, nxt; int ui = 0;
    if (!S.next(0, cur)) return;
    f32x4 acc[2][2][4][2];
#pragma unroll
    for (int a = 0; a < 2; ++a)
#pragma unroll
        for (int b = 0; b < 2; ++b)
#pragma unroll
            for (int m = 0; m < 4; ++m)
#pragma unroll
                for (int n = 0; n < 2; ++n) acc[a][b][m][n] = (f32x4){0.f, 0.f, 0.f, 0.f};
    bf16x8 At[4][2], B0[2][2], B1[2][2];
    const char* cA = (const char*)g.A + (size_t)cur.pm * tstep + (size_t)cur.kofs * 2; const char* cB = (const char*)g.Bt + (size_t)cur.pn * tstep + (size_t)cur.kofs * 2;
    if constexpr (SP2) {
        PG8_STAGE(PG8_SB(0, 0), cB, voffB); PG8_STAGE(PG8_SB(0, 1), cB + hstep, voffB); PG8_STAGE(PG8_SA(0, 0), cA, voffA); PG8_STAGE(PG8_SA(0, 1), cA + hstep, voffA);
        if (wr == 1) PG8_BAR;
        PG8_WAIT_V(2); PG8_BAR;
        PG8_STAGE(PG8_SB(1, 0), cB + kstep, voffB); PG8_STAGE(PG8_SA(1, 0), cA + kstep, voffA); PG8_STAGE(PG8_SB(1, 1), cB + hstep + kstep, voffB);
        PG8_WAIT_V(6); PG8_BAR;
    } else {
        PG8_STAGE(PG8_SB(0, 0), cB, voffB); PG8_STAGE(PG8_SA(0, 0), cA, voffA); PG8_STAGE(PG8_SB(0, 1), cB + hstep, voffB); PG8_STAGE(PG8_SA(0, 1), cA + hstep, voffA);
        if (wr == 1) PG8_BAR;
        PG8_WAIT_V(4); PG8_BAR;
        PG8_STAGE(PG8_SB(1, 0), cB + kstep, voffB); PG8_STAGE(PG8_SA(1, 0), cA + kstep, voffA); PG8_STAGE(PG8_SB(1, 1), cB + hstep + kstep, voffB);
        PG8_WAIT_V(6); PG8_BAR;
    }
    for (;;) {
        const bool has_next = S.next(ui + 1, nxt);
        const char* nA = has_next ? (const char*)g.A + (size_t)nxt.pm * tstep + (size_t)nxt.kofs * 2 : cA; const char* nB = has_next ? (const char*)g.Bt + (size_t)nxt.pn * tstep + (size_t)nxt.kofs * 2 : cB;
        const int nt = cur.nt;
        for (int t = 0; t < nt; t += 2) {
            const bool last = (t == nt - 2);
            const char* a1 = cA + (size_t)(t + 1) * kstep;
            const char* a2 = last ? nA : cA + (size_t)(t + 2) * kstep; const char* b2 = last ? nB : cB + (size_t)(t + 2) * kstep;
            const char* a3 = a2 + kstep; const char* b3 = b2 + kstep;
            if constexpr (SP2) {
            PG8_LDB(B0, 0, 0); PG8_LDB(B1, 0, 1); PG8_SCHED; PG8_LDA(At, 0, 0); PG8_STAGE(PG8_SA(1, 1), a1 + hstep, voffA);
            PG8_WAIT_V(8); PG8_WAIT_L(0); PG8_BAR; PG8_MMA(0, 0, At, B0); PG8_MMA(0, 1, At, B1); PG8_BAR; PG8_SCHED;
            PG8_LDA(At, 0, 1); PG8_STAGE(PG8_SB(0, 0), b2, voffB); PG8_STAGE(PG8_SB(0, 1), b2 + hstep, voffB); PG8_STAGE(PG8_SA(0, 0), a2, voffA);
            PG8_WAIT_V(8); PG8_WAIT_L(0); PG8_BAR; PG8_MMA(1, 0, At, B0); PG8_MMA(1, 1, At, B1); PG8_BAR; PG8_SCHED;
            PG8_LDB(B0, 1, 0); PG8_LDB(B1, 1, 1); PG8_SCHED; PG8_LDA(At, 1, 0); PG8_STAGE(PG8_SA(0, 1), a2 + hstep, voffA);
            PG8_WAIT_V(8); PG8_WAIT_L(0); PG8_BAR; PG8_MMA(0, 0, At, B0); PG8_MMA(0, 1, At, B1); PG8_BAR; PG8_SCHED;
            PG8_LDA(At, 1, 1); PG8_STAGE(PG8_SB(1, 0), b3, voffB); PG8_STAGE(PG8_SB(1, 1), b3 + hstep, voffB); PG8_STAGE(PG8_SA(1, 0), a3, voffA);
            PG8_WAIT_V(8); PG8_WAIT_L(0); PG8_BAR; PG8_MMA(1, 0, At, B0); PG8_MMA(1, 1, At, B1); PG8_BAR; PG8_SCHED;
            } else {
            PG8_LDB(B0, 0, 0); PG8_SCHED; PG8_LDA(At, 0, 0); PG8_STAGE(PG8_SA(1, 1), a1 + hstep, voffA);
            PG8_WAIT_L(8); PG8_BAR; PG8_WAIT_L(0); PG8_MMA(0, 0, At, B0); PG8_BAR; PG8_SCHED;
            PG8_LDB(B1, 0, 1); PG8_STAGE(PG8_SB(0, 0), b2, voffB);
            PG8_BAR; PG8_WAIT_L(0); PG8_MMA(0, 1, At, B1); PG8_BAR;
            PG8_LDA(At, 0, 1); PG8_STAGE(PG8_SA(0, 0), a2, voffA);
            PG8_BAR; PG8_WAIT_L(0); PG8_MMA(1, 0, At, B0); PG8_BAR; PG8_SCHED;
            PG8_STAGE(PG8_SB(0, 1), b2 + hstep, voffB);
            PG8_WAIT_V(6); PG8_BAR; PG8_MMA(1, 1, At, B1); PG8_BAR;
            PG8_LDB(B0, 1, 0); PG8_SCHED; PG8_LDA(At, 1, 0); PG8_STAGE(PG8_SA(0, 1), a2 + hstep, voffA);
            PG8_WAIT_L(8); PG8_BAR; PG8_WAIT_L(0); PG8_MMA(0, 0, At, B0); PG8_BAR; PG8_SCHED;
            PG8_LDB(B1, 1, 1); PG8_STAGE(PG8_SB(1, 0), b3, voffB);
            PG8_BAR; PG8_WAIT_L(0); PG8_MMA(0, 1, At, B1); PG8_BAR;
            PG8_LDA(At, 1, 1); PG8_STAGE(PG8_SA(1, 0), a3, voffA);
            PG8_BAR; PG8_WAIT_L(0); PG8_MMA(1, 0, At, B0); PG8_BAR; PG8_SCHED;
            PG8_STAGE(PG8_SB(1, 1), b3 + hstep, voffB);
            PG8_WAIT_V(6); PG8_BAR; PG8_MMA(1, 1, At, B1); PG8_BAR;
            }
        }
        if constexpr (ALIGN_EPI) { if (wr == 0) PG8_BAR; }
        { int e_fr = fr, e_fq = fq, e_wr = wr, e_wc = wc; asm volatile("" : "+v"(e_fr), "+v"(e_fq), "+s"(e_wr), "+s"(e_wc));
          E(acc, cur, e_wr, e_wc, e_fr, e_fq); }
        if (!has_next) break;
#pragma unroll
        for (int a = 0; a < 2; ++a)
#pragma unroll
            for (int b = 0; b < 2; ++b)
#pragma unroll
                for (int m = 0; m < 4; ++m)
#pragma unroll
                    for (int n = 0; n < 2; ++n) acc[a][b][m][n] = (f32x4){0.f, 0.f, 0.f, 0.f};
        cur = nxt; cA = nA; cB = nB; ++ui;
        if constexpr (ALIGN_EPI) { if (wr == 1) PG8_BAR; }
    }
    PG8_WAIT_V(0);
    if constexpr (!ALIGN_EPI) { if (wr == 0) PG8_BAR; }
    PG8_BAR;
#undef PG8_SA
#undef PG8_SB
#undef PG8_STAGE
#undef PG8_LDA
#undef PG8_LDB
#undef PG8_MMA
#undef PG8_WAIT_V
#undef PG8_WAIT_L
#undef PG8_BAR
#undef PG8_SCHED
}
}

struct EpiSwiglu {
    static constexpr bool PERM = true;
    bf16_t* O;
    __device__ __forceinline__ void operator()(const f32x4 (&acc)[2][2][4][2], const pg8::Unit& u, int wr, int wc, int fr, int fq) const {
        const int row0 = u.pm * 256 + wr * 64 + fr, col0 = u.pn * 128 + wc * 32 + 8 * fq;
#pragma unroll
        for (int ai = 0; ai < 2; ++ai)
#pragma unroll
            for (int m = 0; m < 4; ++m) {
                bf16_t* rowp = O + (size_t)(row0 + ai * 128 + m * 16) * DFF + col0;
                float v[8];
#pragma unroll
                for (int n = 0; n < 2; ++n)
#pragma unroll
                    for (int j = 0; j < 4; ++j) { const float gt = acc[ai][0][m][n][j], up = acc[ai][1][m][n][j]; v[n * 4 + j] = gt * __builtin_amdgcn_rcpf(1.0f + __expf(-gt)) * up; }
                u32x4 w; w.x = cvt_pk_bf16(v[0], v[1]); w.y = cvt_pk_bf16(v[2], v[3]); w.z = cvt_pk_bf16(v[4], v[5]); w.w = cvt_pk_bf16(v[6], v[7]);
                *(u32x4*)rowp = w;
            }
    }
};
struct EpiResid {
    static constexpr bool PERM = false;
    float* xlat; float* xctx; const float* mods_l; int gidx; float scale; float* part; const float* xlat_src;
    __device__ __forceinline__ void operator()(const f32x4 (&acc)[2][2][4][2], const pg8::Unit& u, int wr, int wc, int fr, int fq) const {
        if (u.split) {
            float* pb = part + ((size_t)(u.split - 1) * MCTX + (size_t)(u.pm - 64) * 256) * DM + u.pn * 256 + wc * 32 + 4 * fq;
#pragma unroll
            for (int ai = 0; ai < 2; ++ai)
#pragma unroll
                for (int m = 0; m < 4; ++m) { float* rowp = pb + (size_t)(wr * 64 + fr + ai * 128 + m * 16) * DM;
#pragma unroll
                    for (int bj = 0; bj < 2; ++bj)
#pragma unroll
                        for (int n = 0; n < 2; ++n) *(f32x4*)(rowp + bj * 128 + n * 16) = acc[ai][bj][m][n]; }
            return;
        }
        const int s = u.pm < 64 ? (u.pm >> 4) : 4;
        const float* gate = mods_l + s * 9216 + gidx * 1024;
        float* base = u.pm < 64 ? xlat + (size_t)(u.pm * 256) * DM : xctx + (size_t)((u.pm - 64) * 256) * DM;
        const float* sbase = u.pm < 64 ? xlat_src + (size_t)(u.pm * 256) * DM : base;
        const int col0 = u.pn * 256 + wc * 32 + 4 * fq;
        f32x4 gv[2][2];
#pragma unroll
        for (int bj = 0; bj < 2; ++bj)
#pragma unroll
            for (int n = 0; n < 2; ++n) gv[bj][n] = *(const f32x4*)(gate + col0 + bj * 128 + n * 16) * scale;
#pragma unroll
        for (int ai = 0; ai < 2; ++ai) {
            f32x4 xv[4][2][2];
#pragma unroll
            for (int m = 0; m < 4; ++m) { const float* rowp = sbase + (size_t)(wr * 64 + fr + ai * 128 + m * 16) * DM + col0;
#pragma unroll
                for (int bj = 0; bj < 2; ++bj)
#pragma unroll
                    for (int n = 0; n < 2; ++n) xv[m][bj][n] = *(const f32x4*)(rowp + bj * 128 + n * 16); }
#pragma unroll
            for (int m = 0; m < 4; ++m) { float* rowp = base + (size_t)(wr * 64 + fr + ai * 128 + m * 16) * DM + col0;
#pragma unroll
                for (int bj = 0; bj < 2; ++bj)
#pragma unroll
                    for (int n = 0; n < 2; ++n) *(f32x4*)(rowp + bj * 128 + n * 16) = xv[m][bj][n] + gv[bj][n] * acc[ai][bj][m][n]; }
            asm volatile("" ::: "memory");
        }
    }
};
struct EpiWin {
    static constexpr bool PERM = true;
    bf16_t* pa; float* pr;
    __device__ __forceinline__ void operator()(const f32x4 (&acc)[2][2][4][2], const pg8::Unit& u, int wr, int wc, int fr, int fq) const {
        const int row0 = u.pm * 256 + wr * 64 + fr;
        if (u.pn < 6) {
            const int col0 = u.pn * 256 + wc * 32 + 8 * fq;
#pragma unroll
            for (int ai = 0; ai < 2; ++ai)
#pragma unroll
                for (int m = 0; m < 4; ++m) { bf16_t* rowp = pa + (size_t)(row0 + ai * 128 + m * 16) * 1536 + col0;
#pragma unroll
                    for (int bj = 0; bj < 2; ++bj) { const f32x4 a = acc[ai][bj][m][0], b = acc[ai][bj][m][1];
                        u32x4 w; w.x = cvt_pk_bf16(a[0], a[1]); w.y = cvt_pk_bf16(a[2], a[3]); w.z = cvt_pk_bf16(b[0], b[1]); w.w = cvt_pk_bf16(b[2], b[3]);
                        *(u32x4*)(rowp + bj * 128) = w; } }
        } else {
            const int col0 = (u.pn - 6) * 256 + wc * 32 + 8 * fq;
#pragma unroll
            for (int ai = 0; ai < 2; ++ai)
#pragma unroll
                for (int m = 0; m < 4; ++m) { float* rowp = pr + (size_t)(row0 + ai * 128 + m * 16) * 1792 + col0;
#pragma unroll
                    for (int bj = 0; bj < 2; ++bj)
#pragma unroll
                        for (int n = 0; n < 2; ++n) *(f32x4*)(rowp + bj * 128 + n * 4) = acc[ai][bj][m][n]; }
        }
    }
};

__device__ __forceinline__ const float* xrow_c(const Params& p, int r) { return r < MLAT ? p.out + (size_t)r * DM : p.xc + (size_t)(r - MLAT) * DM; }

__device__ __forceinline__ void phase_init(const Params& p, float* ldsf, const int tid, const int bid) {
    const int wid = tid >> 6, lane = tid & 63;
    for (int i = tid; i < 5 * DM; i += NTH) { const int s = i >> 10, k = i & 1023; const float v = s < 4 ? p.c[s * DM + k] : p.c_ctx[k]; ldsf[i] = v * sigmoidf_(v); }
    __syncthreads();
    float* part = ldsf + 5 * DM;
    for (int it = bid; it < NLAYER * 144; it += gridDim.x) {
        const int l = it / 144, n0 = (it % 144) * 64;
        const float* w = p.w_mod + ((size_t)l * DM + wid * 128) * 9216 + n0 + lane;
        float a0 = 0, a1 = 0, a2 = 0, a3 = 0, a4 = 0;
#pragma unroll 16
        for (int i = 0; i < 128; ++i) { const float wv = __builtin_nontemporal_load(w + (size_t)i * 9216); const int k = wid * 128 + i;
            a0 += ldsf[k] * wv; a1 += ldsf[DM + k] * wv; a2 += ldsf[2 * DM + k] * wv; a3 += ldsf[3 * DM + k] * wv; a4 += ldsf[4 * DM + k] * wv; }
        part[(wid * 5 + 0) * 64 + lane] = a0; part[(wid * 5 + 1) * 64 + lane] = a1; part[(wid * 5 + 2) * 64 + lane] = a2; part[(wid * 5 + 3) * 64 + lane] = a3; part[(wid * 5 + 4) * 64 + lane] = a4;
        __syncthreads();
        if (tid < 320) { const int s = tid >> 6; float v = p.b_mod[l * 9216 + n0 + lane];
#pragma unroll
            for (int q = 0; q < 8; ++q) v += part[(q * 5 + s) * 64 + lane];
            p.mods[((size_t)l * 5 + s) * 9216 + n0 + lane] = v; }
        __syncthreads();
    }
}

struct ConvTile { const float* src; bf16_t* dst; int K, N, mode, k0, n0; };
__device__ __forceinline__ ConvTile conv_decode(const Params& p, int l, int t) {
    ConvTile c; c.mode = 0;
    if (t < 2816) { const int i = t / 1408; t %= 1408; c.src = p.ffn_up + ((size_t)(l * 2 + i)) * DM * 5632; c.dst = p.wb + (i ? WB_UP1 : WB_UP0); c.K = DM; c.N = 5632; c.mode = 1; }
    else if (t < 4224) { t -= 2816; const int i = t / 704; t %= 704; c.src = p.ffn_down + ((size_t)(l * 2 + i)) * DFF * DM; c.dst = p.wb + (i ? WB_DN1 : WB_DN0); c.K = DFF; c.N = DM; }
    else if (t < 5056) { t -= 4224; c.src = p.w_in + (size_t)l * DM * DIN; c.dst = p.wb + WB_WIN; c.K = DM; c.N = DIN; }
    else if (t < 5312) { t -= 5056; c.src = p.w_out + (size_t)l * DM * DM; c.dst = p.wb + WB_WOUT; c.K = DM; c.N = DM; }
    else { t -= 5312; c.mode = 2; c.N = 512;
        if (t < 16) { const int d = t >> 3; t &= 7; c.src = p.decay_w2 + (size_t)(l * 2 + d) * 64 * 512; c.dst = p.lw + d * 32768; c.K = 64; }
        else if (t < 32) { t -= 16; const int d = t >> 3; t &= 7; c.src = p.iclr_a2 + (size_t)(l * 2 + d) * 64 * 512; c.dst = p.lw + 65536 + d * 32768; c.K = 64; }
        else { t -= 32; c.src = p.gate_g2 + (size_t)l * 128 * 512; c.dst = p.lw + 131072; c.K = 128; } }
    const int ntn = c.N / 64, tk = t / ntn, tn = t - tk * ntn; c.k0 = tk * 64; c.n0 = tn * 64;
    return c;
}
__device__ __forceinline__ void phase_convert(const Params& p, int l, float* tile, const int tid, const int bid) {
    const int ty = tid >> 6, tx = tid & 63;
    float cur[8], nxt[8];
    if (bid < 5360) { const ConvTile c = conv_decode(p, l, bid);
#pragma unroll
        for (int i = 0; i < 8; ++i) cur[i] = __builtin_nontemporal_load(c.src + (size_t)(c.k0 + ty + 8 * i) * c.N + c.n0 + tx); }
    for (int it = bid; it < 5360; it += gridDim.x) {
        const int itn = it + gridDim.x;
        if (itn < 5360) { const ConvTile cn = conv_decode(p, l, itn);
#pragma unroll
            for (int i = 0; i < 8; ++i) nxt[i] = __builtin_nontemporal_load(cn.src + (size_t)(cn.k0 + ty + 8 * i) * cn.N + cn.n0 + tx); }
        const ConvTile c = conv_decode(p, l, it);
#pragma unroll
        for (int i = 0; i < 8; ++i) tile[(ty + 8 * i) * 65 + tx] = cur[i];
        __syncthreads();
        const int nl = tid >> 3, kc = tid & 7, n = c.n0 + nl;
        const int row = c.mode == 1 ? (n < DFF ? ((n >> 7) * 256 + (n & 127)) : (((n - DFF) >> 7) * 256 + 128 + ((n - DFF) & 127))) : n;
        float v[8];
#pragma unroll
        for (int j = 0; j < 8; ++j) v[j] = tile[(kc * 8 + j) * 65 + nl];
        u32x4 w;
        if (c.mode == 2) { w.x = pk_f16(v[0], v[1]); w.y = pk_f16(v[2], v[3]); w.z = pk_f16(v[4], v[5]); w.w = pk_f16(v[6], v[7]); }
        else { w.x = cvt_pk_bf16(v[0], v[1]); w.y = cvt_pk_bf16(v[2], v[3]); w.z = cvt_pk_bf16(v[4], v[5]); w.w = cvt_pk_bf16(v[6], v[7]); }
        *(u32x4*)(c.dst + (size_t)row * c.K + c.k0 + kc * 8) = w;
        __syncthreads();
#pragma unroll
        for (int i = 0; i < 8; ++i) cur[i] = nxt[i];
    }
}

__device__ __forceinline__ void phase_norm(const Params& p, int l, int which, const int tid, const int bid, const int npart, const float* pgate, const float pscale, const float* xlsrc, const float* xcsrc) {
    const int wid = tid >> 6, lane = tid & 63;
    const float* gain = p.norm_gain + (size_t)(l * 3 + which) * DM;
#pragma unroll 2
    for (int r = bid * 8 + wid; r < MT; r += gridDim.x * 8) {
        const float* xr = r < MLAT ? xlsrc + (size_t)r * DM : xcsrc + (size_t)(r - MLAT) * DM;
        const int s = r < MLAT ? (r >> 12) : 4;
        const float* md = p.mods + ((size_t)l * 5 + s) * 9216;
        const float* shift = md + (3 * which) * DM; const float* scale = md + (3 * which + 1) * DM;
        f32x4 v[4]; float ss = 0.f;
#pragma unroll
        for (int i = 0; i < 4; ++i) { v[i] = *(const f32x4*)(xr + (lane + 64 * i) * 4);
            if (r >= MLAT && npart > 0) {
                f32x4 a = {0.f, 0.f, 0.f, 0.f};
                for (int q = 0; q < npart; ++q) a += *(const f32x4*)(p.part + ((size_t)q * MCTX + (r - MLAT)) * DM + (lane + 64 * i) * 4);
                v[i] += a * (*(const f32x4*)(pgate + (lane + 64 * i) * 4)) * pscale;
                *(f32x4*)(p.xc + (size_t)(r - MLAT) * DM + (lane + 64 * i) * 4) = v[i];
            }
            ss += v[i][0] * v[i][0] + v[i][1] * v[i][1] + v[i][2] * v[i][2] + v[i][3] * v[i][3]; }
        ss = wave_sum(ss);
        const float rstd = rsqrtf(ss * (1.0f / DM) + 1e-6f);
#pragma unroll
        for (int i = 0; i < 4; ++i) { const int c = (lane + 64 * i) * 4;
            const f32x4 gn = *(const f32x4*)(gain + c), sc = *(const f32x4*)(scale + c), sf = *(const f32x4*)(shift + c);
            f32x4 y = (v[i] * rstd) * gn; y = y * (1.0f + sc) + sf;
            u32x2 w; w.x = cvt_pk_bf16(y[0], y[1]); w.y = cvt_pk_bf16(y[2], y[3]);
            *(u32x2*)(p.h + (size_t)r * DM + c) = w; }
    }
}

__device__ __forceinline__ void phase_prep(const Params& p, int l, float* lin, const int tid, const int bid) {
    const int wid = tid >> 6, lane = tid & 63, c = tid;
    const float* mu = p.shift_mu + (size_t)l * 1792;
    const float mu_r = mu[c], mu_k = mu[512 + c], mu_v = mu[1024 + c];
    const float kkc = p.key_k[l * 512 + c], kac = p.key_a[l * 512 + c], uc = p.bonus_u[l * 512 + c];
    const float w0f = p.decay_w0[(l * 2 + 0) * 512 + c], w0b = p.decay_w0[(l * 2 + 1) * 512 + c];
    const float a0f = p.iclr_a0[(l * 2 + 0) * 512 + c], a0b = p.iclr_a0[(l * 2 + 1) * 512 + c];
    const float qgn = p.q_gain[l * 64 + lane] * 0.125f, kgn = p.k_gain[l * 64 + lane];
    const float* dw2f = p.decay_w2 + (size_t)(l * 2 + 0) * 64 * 512 + c; const float* dw2b = p.decay_w2 + (size_t)(l * 2 + 1) * 64 * 512 + c;
    const float* ia2f = p.iclr_a2 + (size_t)(l * 2 + 0) * 64 * 512 + c; const float* ia2b = p.iclr_a2 + (size_t)(l * 2 + 1) * 64 * 512 + c;
    const float* gg2 = p.gate_g2 + (size_t)l * 128 * 512 + c;
    for (int tile = bid; tile < 1024 + 256; tile += gridDim.x) {
        const int t0 = tile < 1024 ? tile * 16 : MLAT + (tile - 1024) * 4, ntok = tile < 1024 ? 16 : 4;
        int seq_lo, seq_hi;
        if (t0 < MLAT) { seq_lo = t0 & ~4095; seq_hi = seq_lo + 4096; } else { seq_lo = MLAT + ((t0 - MLAT) & ~255); seq_hi = seq_lo + 256; }
        __syncthreads();
#pragma unroll
        for (int i = 0; i < 8; ++i) {
            const int idx = tid + NTH * i, tt = idx >> 8, j = idx & 255, t = t0 + tt;
            if (tt >= ntok) continue;
            const float pc = p.pr[(size_t)t * 1792 + 1536 + j];
            const float pm = t > seq_lo ? p.pr[(size_t)(t - 1) * 1792 + 1536 + j] : 0.f;
            const float pp = t + 1 < seq_hi ? p.pr[(size_t)(t + 1) * 1792 + 1536 + j] : 0.f;
            const float xs = pc + mu[1536 + j] * (0.5f * (pm + pp) - pc);
            const float f = j < 64 ? (1.0f - 2.0f * __builtin_amdgcn_rcpf(1.0f + __expf(2.0f * xs))) : (j < 128 ? xs : __builtin_amdgcn_rcpf(1.0f + __expf(-xs)));
            ((_Float16*)lin)[tt * 264 + j] = (_Float16)f;
        }
        __syncthreads();
        float dwf[16], dwb[16], af[16], ab[16], gg[16];
        {
            const int fr = lane & 15, fq = lane >> 4;
            const _Float16* linh = (const _Float16*)lin;
            bf16_t* outh = (bf16_t*)(lin + 4096);
            const bf16_t* lwp = p.lw;
#pragma unroll
            for (int m = 0; m < 5; ++m) {
                const int KK = m < 4 ? 64 : 128, jofs = m < 2 ? 0 : (m < 4 ? 64 : 128);
                const bf16_t* wbase = lwp + (size_t)m * 32768;
#pragma unroll
                for (int ct = 0; ct < 4; ++ct) {
                    f32x4 acc = {0.f, 0.f, 0.f, 0.f};
#pragma unroll
                    for (int ks = 0; ks < 4; ++ks) {
                        if (ks * 32 < KK) {
                            const f16x8 a = *(const f16x8*)(linh + fr * 264 + jofs + ks * 32 + fq * 8);
                            const f16x8 bfr = *(const f16x8*)(wbase + (size_t)(wid * 64 + ct * 16 + fr) * KK + ks * 32 + fq * 8);
                            acc = __builtin_amdgcn_mfma_f32_16x16x32_f16(a, bfr, acc, 0, 0, 0);
                        }
                    }
#pragma unroll
                    for (int r = 0; r < 4; ++r) outh[(m * 16 + fq * 4 + r) * 520 + wid * 64 + ct * 16 + fr] = f2h(acc[r]);
                }
            }
            __syncthreads();
#pragma unroll
            for (int tt = 0; tt < 16; ++tt) {
                dwf[tt] = h2f(outh[(0 * 16 + tt) * 520 + c]); dwb[tt] = h2f(outh[(1 * 16 + tt) * 520 + c]);
                af[tt] = h2f(outh[(2 * 16 + tt) * 520 + c]); ab[tt] = h2f(outh[(3 * 16 + tt) * 520 + c]);
                gg[tt] = h2f(outh[(4 * 16 + tt) * 520 + c]);
            }
        }
        const float* prr = p.pr + c;
        float r_prev = t0 > seq_lo ? prr[(size_t)(t0 - 1) * 1792] : 0.f, r_cur = prr[(size_t)t0 * 1792];
        float k_prev = t0 > seq_lo ? prr[(size_t)(t0 - 1) * 1792 + 512] : 0.f, k_cur = prr[(size_t)t0 * 1792 + 512];
        float v_prev = t0 > seq_lo ? prr[(size_t)(t0 - 1) * 1792 + 1024] : 0.f, v_cur = prr[(size_t)t0 * 1792 + 1024];
        const bool h1 = t0 + 1 < seq_hi;
        float r_nx = h1 ? prr[(size_t)(t0 + 1) * 1792] : 0.f, k_nx = h1 ? prr[(size_t)(t0 + 1) * 1792 + 512] : 0.f, v_nx = h1 ? prr[(size_t)(t0 + 1) * 1792 + 1024] : 0.f;
        unsigned short pq_n = p.pa[(size_t)t0 * 1536 + c], pk_n = p.pa[(size_t)t0 * 1536 + 512 + c], pv_n = p.pa[(size_t)t0 * 1536 + 1024 + c];
        unsigned vtp[8] = {0u, 0u, 0u, 0u, 0u, 0u, 0u, 0u};
#pragma unroll
        for (int tt = 0; tt < 16; ++tt) {
            if (tt >= ntok) continue;
            const int t = t0 + tt;
            const bool h2 = (tt + 1 < ntok) && (t + 2 < seq_hi);
            const float r_n2 = h2 ? prr[(size_t)(t + 2) * 1792] : 0.f, k_n2 = h2 ? prr[(size_t)(t + 2) * 1792 + 512] : 0.f, v_n2 = h2 ? prr[(size_t)(t + 2) * 1792 + 1024] : 0.f;
            const unsigned short pq_c = pq_n, pk_c = pk_n, pv_c = pv_n;
            if (tt + 1 < ntok) { pq_n = p.pa[(size_t)(t + 1) * 1536 + c]; pk_n = p.pa[(size_t)(t + 1) * 1536 + 512 + c]; pv_n = p.pa[(size_t)(t + 1) * 1536 + 1024 + c]; }
            const float rs = r_cur + mu_r * (0.5f * (r_prev + r_nx) - r_cur);
            const float ks = k_cur + mu_k * (0.5f * (k_prev + k_nx) - k_cur);
            const float vs = v_cur + mu_v * (0.5f * (v_prev + v_nx) - v_cur);
            r_prev = r_cur; r_cur = r_nx; r_nx = r_n2; k_prev = k_cur; k_cur = k_nx; k_nx = k_n2; v_prev = v_cur; v_cur = v_nx; v_nx = v_n2;
            float kkv = ks * kkc;
            float z = -(w0f + dwf[tt]); float sp = fmaxf(z, 0.f) + __logf(1.0f + __expf(-fabsf(z)));
            const float decf = __expf(-__expf(-sp - 0.5f));
            const float aF = __builtin_amdgcn_rcpf(1.0f + __expf(-(a0f + af[tt])));
            const float kdf = ks * (1.0f + (aF - 1.0f) * kac);
            z = -(w0b + dwb[tt]); sp = fmaxf(z, 0.f) + __logf(1.0f + __expf(-fabsf(z)));
            const float decb = __expf(-__expf(-sp - 0.5f));
            const float aB = __builtin_amdgcn_rcpf(1.0f + __expf(-(a0b + ab[tt])));
            const float kdb = ks * (1.0f + (aB - 1.0f) * kac);
            bf16_t* par = p.pa + (size_t)t * 1536;
            const float q = bf2f(pq_c), kx = bf2f(pk_c);
            const float rz = red4(kkv * kkv, rs * (kdf + kdb) * uc, q * q, kx * kx);
            const float n2 = __builtin_bit_cast(float, __builtin_amdgcn_readlane(__builtin_bit_cast(int, rz), 0));
            const float bsum = __builtin_bit_cast(float, __builtin_amdgcn_readlane(__builtin_bit_cast(int, rz), 16));
            const float qs = __builtin_bit_cast(float, __builtin_amdgcn_readlane(__builtin_bit_cast(int, rz), 32));
            const float kss = __builtin_bit_cast(float, __builtin_amdgcn_readlane(__builtin_bit_cast(int, rz), 48));
            kkv *= rsqrtf(fmaxf(n2, 1e-24f));
            const size_t sb = ((size_t)t * 8 + wid) * 192 + lane;
            {
                const size_t th = (size_t)t * 8 + wid, thb = th + (size_t)MT * 8;
                p.shh[th * 192 + lane] = f2h(rs); p.shh[th * 192 + 64 + lane] = f2h(kkv); p.shh[th * 192 + 128 + lane] = f2h(vs);
                p.dw[th * 64 + lane] = decf; p.dw[thb * 64 + lane] = decb;
                p.dkb[th * 128 + lane] = f2h(kdf); p.dkb[th * 128 + 64 + lane] = f2h(kkv * aF);
                p.dkb[thb * 128 + lane] = f2h(kdb); p.dkb[thb * 128 + 64 + lane] = f2h(kkv * aB);
            }
            p.g[(size_t)t * 512 + c] = gg[tt];
            if (lane == 0) p.bon[(size_t)t * 8 + wid] = bsum;
            par[c] = f2bf(q * rsqrtf(qs * (1.0f / 64.0f) + 1e-6f) * qgn);
            par[512 + c] = f2bf(kx * rsqrtf(kss * (1.0f / 64.0f) + 1e-6f) * kgn);
            const unsigned vb16 = pv_c;
            if (tt & 1) vtp[tt >> 1] |= vb16 << 16; else vtp[tt >> 1] = vb16;
        }
        if (ntok == 16) { u32x4 w0 = {vtp[0], vtp[1], vtp[2], vtp[3]}, w1 = {vtp[4], vtp[5], vtp[6], vtp[7]};
            *(u32x4*)(p.vT + (size_t)c * MT + t0) = w0; *(u32x4*)(p.vT + (size_t)c * MT + t0 + 8) = w1; }
        else { u32x2 w0 = {vtp[0], vtp[1]}; *(u32x2*)(p.vT + (size_t)c * MT + t0) = w0; }
    }
}

__device__ __forceinline__ void phase_attn(const Params& p, int l, float* ldsf, bool emit_ctx, const int tid, const int bid) {
    const int wid = tid >> 6, lane = tid & 63, fr = lane & 15, fq = lane >> 4, qg = wid & 3, rsel = wid >> 2;
    unsigned char* ldsb = (unsigned char*)ldsf;
    constexpr int KC_OFF = 2048, VC_OFF = 2048 + 256 * 144, KL_OFF = VC_OFF + 64 * 528;
    static_assert(KL_OFF + 576 * 144 <= LDS_MAIN, "attention staging exceeds LDS");
    const int kc0 = qg == 0 ? 0 : (qg == 1 ? 8 : (qg == 2 ? 24 : 32));
    const int cq = qg * 16 + fr, cs = min(max(cq - 8, 0), 48);
    const int keyA = (fr >> 2) * 8 + (fr & 3);
    float gq = 0.f, gk = 0.f;
    for (int i = 0; i < 64; ++i) { gq = fmaxf(gq, fabsf(p.q_gain[l * 64 + i])); gk = fmaxf(gk, fabsf(p.k_gain[l * 64 + i])); }
    struct KV { bf16x8 a0[2], a1[2]; u32x4 v[4]; };
    for (int bb = bid; bb < 256; bb += gridDim.x) {
        const int bh = bb >> 3, b = bh >> 3, h = bh & 7, sub = bb & 7;
        __syncthreads();
        float bm = 0.f;
        for (int i = tid; i < 465; i += NTH) { const float v = p.na_bias[((size_t)l * 8 + h) * 465 + i]; ldsf[i] = v; bm = fmaxf(bm, fabsf(v)); }
        bm = wave_max(bm);
        if (lane == 0) ldsf[480 + wid] = bm;
#pragma unroll
        for (int i = 0; i < 4; ++i) {
            const int idx = tid + NTH * i;
            { const int key = idx >> 3, part = idx & 7;
              *(u32x4*)(ldsb + KC_OFF + key * 144 + part * 16) = *(const u32x4*)(p.pa + (size_t)(MLAT + b * 256 + key) * 1536 + 512 + h * 64 + part * 8); }
            { const int d = idx >> 5, part = idx & 31;
              *(u32x4*)(ldsb + VC_OFF + d * 528 + part * 16) = *(const u32x4*)(p.vT + (size_t)(h * 64 + d) * MT + MLAT + b * 256 + part * 8); }
        }
        __syncthreads();
        bm = 0.f;
#pragma unroll
        for (int i = 0; i < 8; ++i) bm = fmaxf(bm, ldsf[480 + i]);
        const float Mb = 8.0f * gq * gk * 1.02f + bm;
        const int nit = 4 + (emit_ctx ? 1 : 0);
        for (int n = 0; n < nit; ++n) {
            const bool isctx = n == 4;
            if (isctx && qg != 0) continue;
            const int rowbase = min(max(2 * (sub * 4 + n) - 4, 0), 56);
            if (!isctx) {
                __syncthreads();
#pragma unroll
                for (int i = 0; i < 9; ++i) { const int idx = tid + NTH * i, key = idx >> 3, part = idx & 7, krow = rowbase + (key >> 6);
                    if (krow < 64) *(u32x4*)(ldsb + KL_OFF + key * 144 + part * 16) = *(const u32x4*)(p.pa + (size_t)(b * 4096 + krow * 64 + (key & 63)) * 1536 + 512 + h * 64 + part * 8); }
                __syncthreads();
            }
            const int i_row = isctx ? 0 : 2 * (sub * 4 + n) + rsel;
            const int qbase = isctx ? MLAT + b * 256 + (sub * 2 + rsel) * 16 : b * 4096 + i_row * 64 + qg * 16;
            bf16x8 qf[2];
#pragma unroll
            for (int ks = 0; ks < 2; ++ks) qf[ks] = *(const bf16x8*)(p.pa + (size_t)(qbase + fr) * 1536 + h * 64 + ks * 32 + fq * 8);
            f32x4 oacc[4];
#pragma unroll
            for (int dt = 0; dt < 4; ++dt) oacc[dt] = (f32x4){0.f, 0.f, 0.f, 0.f};
            float lsum = 0.f;
            const bf16_t* vbase = p.vT + (size_t)(h * 64 + fr) * MT + fq * 8;
            const int start = min(max(i_row - 4, 0), 56);
            auto load_kv = [&](int s, KV& kv) {
                const int ktok0 = b * 4096 + (start + s) * 64 + kc0;
                const int kl0 = (start + s - rowbase) * 64 + kc0 + keyA;
#pragma unroll
                for (int ks = 0; ks < 2; ++ks) { kv.a0[ks] = *(const bf16x8*)(ldsb + KL_OFF + kl0 * 144 + (ks * 32 + fq * 8) * 2); kv.a1[ks] = *(const bf16x8*)(ldsb + KL_OFF + (kl0 + 4) * 144 + (ks * 32 + fq * 8) * 2); }
#pragma unroll
                for (int dt = 0; dt < 4; ++dt) kv.v[dt] = *(const u32x4*)(vbase + (size_t)(dt * 16) * MT + ktok0);
            };
            auto load_kv_ctx = [&](int u, KV& kv) {
#pragma unroll
                for (int ks = 0; ks < 2; ++ks) { kv.a0[ks] = *(const bf16x8*)(ldsb + KC_OFF + (u * 32 + keyA) * 144 + (ks * 32 + fq * 8) * 2); kv.a1[ks] = *(const bf16x8*)(ldsb + KC_OFF + (u * 32 + keyA + 4) * 144 + (ks * 32 + fq * 8) * 2); }
#pragma unroll
                for (int dt = 0; dt < 4; ++dt) kv.v[dt] = *(const u32x4*)(ldsb + VC_OFF + (dt * 16 + fr) * 528 + (u * 32 + fq * 8) * 2);
            };
            auto compute = [&](int s, bool local, const KV& kv) {
                f32x4 s0 = {0.f, 0.f, 0.f, 0.f}, s1 = {0.f, 0.f, 0.f, 0.f};
#pragma unroll
                for (int ks = 0; ks < 2; ++ks) { s0 = __builtin_amdgcn_mfma_f32_16x16x32_bf16(kv.a0[ks], qf[ks], s0, 0, 0, 0); s1 = __builtin_amdgcn_mfma_f32_16x16x32_bf16(kv.a1[ks], qf[ks], s1, 0, 0, 0); }
                const float* bt = ldsf + (local ? (start + s - i_row + 7) * 31 : 0);
                float e[8];
#pragma unroll
                for (int j = 0; j < 4; ++j) {
                    const int kc = kc0 + fq * 8 + j, kc2 = kc + 4;
                    const int d0 = min(max(kc - cq + 15, 0), 30), d1 = min(max(kc2 - cq + 15, 0), 30);
                    const bool v0 = !local || (kc >= cs && kc < cs + 16), v1 = !local || (kc2 >= cs && kc2 < cs + 16);
                    const float b0v = local ? bt[d0] : 0.f, b1v = local ? bt[d1] : 0.f;
                    e[j] = v0 ? __expf(s0[j] + b0v - Mb) : 0.f;
                    e[4 + j] = v1 ? __expf(s1[j] + b1v - Mb) : 0.f;
                    lsum += e[j] + e[4 + j];
                }
                u32x4 pw; pw.x = cvt_pk_bf16(e[0], e[1]); pw.y = cvt_pk_bf16(e[2], e[3]); pw.z = cvt_pk_bf16(e[4], e[5]); pw.w = cvt_pk_bf16(e[6], e[7]);
                const bf16x8 pf = __builtin_bit_cast(bf16x8, pw);
#pragma unroll
                for (int dt = 0; dt < 4; ++dt) oacc[dt] = __builtin_amdgcn_mfma_f32_16x16x32_bf16(pf, __builtin_bit_cast(bf16x8, kv.v[dt]), oacc[dt], 0, 0, 0);
            };
            KV ka, kb;
            if (!isctx) {
                load_kv(0, ka);
                for (int s = 0; s < 8; s += 2) {
                    load_kv(s + 1, kb);
                    compute(s, true, ka);
                    if (s + 2 < 8) load_kv(s + 2, ka);
                    compute(s + 1, true, kb);
                }
            }
            for (int u = 0; u < 8; ++u) { load_kv_ctx(u, ka); compute(u, false, ka); }
            lsum = swapadd16(lsum, lsum); lsum = swapadd32(lsum, lsum);
#pragma unroll
            for (int j = 0; j < 4; ++j) {
                const float lq = __builtin_bit_cast(float, __builtin_amdgcn_ds_bpermute((fq * 4 + j) * 4, __builtin_bit_cast(int, lsum)));
                const float inv = 1.0f / lq;
                bf16_t* orow = p.h + (size_t)(qbase + fq * 4 + j) * DM + h * 64 + fr;
#pragma unroll
                for (int dt = 0; dt < 4; ++dt) orow[dt * 16] = f2bf(oacc[dt][j] * inv);
            }
        }
    }
}

__device__ __forceinline__ int scan_tok(int s, int b, int dir) { return s < 256 ? MLAT + b * 256 + (dir ? 255 - s : s) : b * 4096 + (dir ? 4095 - (s - 256) : (s - 256)); }
__device__ __forceinline__ void phase_scan(const Params& p, int l, float* ldsf, const int tid, const int bid) {
    const int wid = tid >> 6, lane = tid & 63;
    constexpr int CH = 32, NSTEP = 4352, NCHUNK = NSTEP / CH, NLD = 7;
    float* outb = ldsf + 2 * CH * 384;
#define SCAN_BAR() asm volatile("s_waitcnt lgkmcnt(0)\n\ts_barrier" ::: "memory")
#define SCAN_ISSUE(REG, chunk) do { _Pragma("unroll") for (int i = 0; i < NLD; ++i) { \
        const int idx = lt + 256 * i; \
        if (i < 2) { const int st = idx >> 4, part = idx & 15; const size_t th = (size_t)scan_tok((chunk) * CH + st, b, dir) * 8 + h; \
            REG[i] = *(const u32x4*)(dwp + th * 64 + part * 4); } \
        else { const int j = idx - 512, st = j / 40, r = j - st * 40, vq = r >> 3, part = r & 7; const size_t th = (size_t)scan_tok((chunk) * CH + st, b, dir) * 8 + h; \
            const bf16_t* src = vq < 3 ? p.shh + th * 192 + vq * 64 : dkp + th * 128 + (vq - 3) * 64; \
            REG[i] = *(const u32x4*)(src + part * 8); } } } while (0)
#define SCAN_WRITE(REG, chunk) do { float* dstb = ldsf + ((chunk) & 1) * (CH * 384); _Pragma("unroll") for (int i = 0; i < NLD; ++i) { \
        const int idx = lt + 256 * i; \
        if (i < 2) { const int st = idx >> 4, part = idx & 15; *(u32x4*)(dstb + st * 384 + 64 + part * 4) = REG[i]; } \
        else { const int j = idx - 512, st = j / 40, r = j - st * 40, vq = r >> 3, part = r & 7; \
            const int lv = vq == 0 ? 3 : (vq == 1 ? 0 : (vq == 2 ? 5 : (vq == 3 ? 2 : 4)));        \
            float* d = dstb + st * 384 + lv * 64 + part * 8; const u32x4 q = REG[i]; \
            f32x4 lo, hi; \
            lo[0] = h2f((bf16_t)(q.x & 0xffffu)); lo[1] = h2f((bf16_t)(q.x >> 16)); lo[2] = h2f((bf16_t)(q.y & 0xffffu)); lo[3] = h2f((bf16_t)(q.y >> 16)); \
            hi[0] = h2f((bf16_t)(q.z & 0xffffu)); hi[1] = h2f((bf16_t)(q.z >> 16)); hi[2] = h2f((bf16_t)(q.w & 0xffffu)); hi[3] = h2f((bf16_t)(q.w >> 16)); \
            if (vq == 4) { lo = -lo; hi = -hi; }        \
            *(f32x4*)d = lo; *(f32x4*)(d + 4) = hi; } } } while (0)
#define SCAN_LOADER(REG, c) do { \
        if ((c) + 1 < NCHUNK) SCAN_WRITE(REG, (c) + 1); \
        if ((c) + 3 < NCHUNK) SCAN_ISSUE(REG, (c) + 3); \
        if ((c) >= 1 && lt < CH * 4) { const int st = lt >> 2, part = lt & 3; const int s = ((c) - 1) * CH + st - 1; \
            if (s >= 0) { const float* ob_ = outb + (((c) - 1) & 1) * (CH * 64) + st * 64 + part * 16; f32x4 o4; \
                _Pragma("unroll") for (int e = 0; e < 4; ++e) { const f32x4 q4 = *(const f32x4*)(ob_ + e * 4); o4[e] = (q4[0] + q4[1]) + (q4[2] + q4[3]); } \
                *(f32x4*)(op + (size_t)scan_tok(s, b, dir) * 512 + part * 4) = o4; } } } while (0)
    for (int unit = bid; unit < 256; unit += gridDim.x) {
        const int chain = (unit >> 5) * 8 + (unit & 7), quarter = (unit >> 3) & 3;
        const int dir = chain >> 5, b = (chain >> 3) & 3, h = chain & 7;
        const float* dwp = p.dw + (size_t)dir * MT * 8 * 64; const bf16_t* dkp = p.dkb + (size_t)dir * MT * 8 * 128;
        float* op = p.o + (size_t)dir * MT * 512 + h * 64 + quarter * 16;
        const int lt = tid - 256;
        u32x4 RA[NLD], RB[NLD];
        __syncthreads();
        if (wid >= 4) { SCAN_ISSUE(RA, 0); SCAN_WRITE(RA, 0); SCAN_ISSUE(RA, 1); SCAN_ISSUE(RB, 2); }
        SCAN_BAR();
        f32x4 S4 = {0.f, 0.f, 0.f, 0.f};
        const int j0 = wid * 4, g = lane >> 4, kl = lane & 15;
        f32x4 rvp = {0.f, 0.f, 0.f, 0.f};
        auto compute_chunk = [&](int c) {
            const float* bufc = ldsf + (c & 1) * (CH * 384) + kl * 4;
            const float* bufv = ldsf + (c & 1) * (CH * 384) + 320 + quarter * 16 + j0 + g;
            float* ob = outb + (c & 1) * (CH * 64) + (j0 + g) * 4 + (kl >> 2);
            f32x4 n_kk = *(const f32x4*)(bufc), n_w = *(const f32x4*)(bufc + 64), n_kv = *(const f32x4*)(bufc + 128), n_rv = *(const f32x4*)(bufc + 192), n_bb = *(const f32x4*)(bufc + 256);
            float n_v = bufv[0];
#pragma unroll
            for (int st = 0; st < CH; ++st) {
                const f32x4 kk = n_kk, w = n_w, kv = n_kv, rv = n_rv, bb = n_bb;
                const float v = n_v;
                if (st + 1 < CH) {
                    const float* bs = bufc + (st + 1) * 384;
                    n_kk = *(const f32x4*)(bs); n_w = *(const f32x4*)(bs + 64); n_kv = *(const f32x4*)(bs + 128); n_rv = *(const f32x4*)(bs + 192); n_bb = *(const f32x4*)(bs + 256);
                    n_v = bufv[(st + 1) * 384];
                }
                const f32x2 Slo = {S4[0], S4[1]}, Shi = {S4[2], S4[3]};
                f32x2 pa = Slo * (f32x2){kk[0], kk[1]}; pa = Shi * (f32x2){kk[2], kk[3]} + pa;
                f32x2 qa = Slo * (f32x2){rvp[0], rvp[1]}; qa = Shi * (f32x2){rvp[2], rvp[3]} + qa;
                float z = pa[0] + pa[1], zo = qa[0] + qa[1];
                const f32x4 T4 = S4 * w + kv * v;
                z += dppf<0xB1>(z); zo += dppf<0xB1>(zo);
                z += dppf<0x4E>(z); zo += dppf<0x4E>(zo);
                z += dppf<0x124>(z);
                z += dppf<0x128>(z);
                S4 = bb * z + T4;
                ob[st * 64] = zo;
                rvp = rv;
            }
        };
        for (int c = 0; c < NCHUNK; c += 2) {
            if (wid >= 4) SCAN_LOADER(RA, c); else compute_chunk(c);
            SCAN_BAR();
            if (wid >= 4) SCAN_LOADER(RB, c + 1); else compute_chunk(c + 1);
            SCAN_BAR();
        }
        if (wid >= 4) {
            if (lt < CH * 4) { const int st = lt >> 2, part = lt & 3; const int s = (NCHUNK - 1) * CH + st - 1;
                const float* ob_ = outb + ((NCHUNK - 1) & 1) * (CH * 64) + st * 64 + part * 16; f32x4 o4;
#pragma unroll
                for (int e = 0; e < 4; ++e) { const f32x4 q4 = *(const f32x4*)(ob_ + e * 4); o4[e] = (q4[0] + q4[1]) + (q4[2] + q4[3]); }
                *(f32x4*)(op + (size_t)scan_tok(s, b, dir) * 512 + part * 4) = o4; }
        } else {
            const f32x4 qk = S4 * rvp;
            float zo = (qk[0] + qk[1]) + (qk[2] + qk[3]);
            zo += dppf<0xB1>(zo); zo += dppf<0x4E>(zo); zo += dppf<0x124>(zo); zo += dppf<0x128>(zo);
            if (kl == 0) op[(size_t)scan_tok(NSTEP - 1, b, dir) * 512 + j0 + g] = zo;
        }
    }
#undef SCAN_BAR
#undef SCAN_ISSUE
#undef SCAN_WRITE
#undef SCAN_LOADER
}

__device__ __forceinline__ void phase_readout(const Params& p, int l, const int tid, const int bid) {
    const int wid = tid >> 6, lane = tid & 63, c = tid;
    const float lg = p.lnx_gain[l * 512 + c], lb = p.lnx_bias[l * 512 + c];
    const float* of = p.o; const float* ob = p.o + (size_t)MT * 512;
    for (int tb = bid; tb < MT; tb += 4 * gridDim.x) {
        float o[4], bn[4], vv[4], gg[4];
#pragma unroll
        for (int j = 0; j < 4; ++j) { const int t = tb + j * gridDim.x; const bool ok = t < MT; const size_t tt = ok ? t : 0;
            o[j] = of[tt * 512 + c] + ob[tt * 512 + c]; bn[j] = p.bon[tt * 8 + wid]; vv[j] = h2f(p.shh[(tt * 8 + wid) * 192 + 128 + lane]); gg[j] = p.g[tt * 512 + c]; }
#pragma unroll
        for (int j = 0; j < 4; ++j) { const int t = tb + j * gridDim.x;
            const float mean = wave_sum(o[j]) * (1.0f / 64.0f);
            const float d = o[j] - mean;
            const float var = wave_sum(d * d) * (1.0f / 64.0f);
            float y = d * rsqrtf(var + 64e-5f) * lg + lb;
            y += bn[j] * vv[j];
            y *= gg[j];
            if (t < MT) p.h[(size_t)t * DM + 512 + c] = f2bf(y); }
    }
}

__global__ void __launch_bounds__(NTH, 2) mega(Params p) {
    extern __shared__ __attribute__((aligned(16))) unsigned char shm[];
    cg::grid_group grid = cg::this_grid();
    float* ldsf = (float*)shm;
    LAS unsigned char* ldsg = (LAS unsigned char*)shm;
    volatile LAS unsigned* xbst = (volatile LAS unsigned*)(ldsg + LDS_MAIN);
    if (threadIdx.x == 0) { xbst[0] = 0u; xbst[1] = 0u; }
    __syncthreads();
    const XcdBarrier xb = xcd_barrier_post(p.bar, xbst);
    const int wave_s = __builtin_amdgcn_readfirstlane(threadIdx.x >> 6);
    for (int ph = p.lo; ph < p.hi; ++ph) {
        int tid, bid = blockIdx.x;
        asm volatile("v_mbcnt_lo_u32_b32 %0, -1, 0\n\tv_mbcnt_hi_u32_b32 %0, -1, %0" : "=v"(tid));
        tid += wave_s * 64;
        asm volatile("" : "+v"(tid), "+s"(bid));
        if (ph == 0) {
            phase_init(p, ldsf, tid, bid);
        } else {
            const int l = (ph - 1) / 12, k = (ph - 1) % 12;
            pg8::StaticOrder S;
            const bool last = l == NLAYER - 1;
            const float* mods_l = p.mods + (size_t)l * 5 * 9216;
            switch (k) {
                case 0: phase_convert(p, l, ldsf, tid, bid);
                        phase_norm(p, l, 0, tid, bid, l > 0 ? 4 : 0, p.mods + ((size_t)(l > 0 ? l - 1 : 0) * 5 + 4) * 9216 + 8 * 1024, 0.5f, l == 0 ? p.x : p.out, l == 0 ? p.ctx : p.xc); break;
                case 1: case 10: { const int M = (k == 10 && last) ? MLAT : MT; pg8::Gemm g{p.h, p.wb + (k == 1 ? WB_UP0 : WB_UP1), M, 5632, DM}; S.init(M, 5632, DM, gridDim.x, bid, 0); EpiSwiglu E{p.act}; pg8::gemm_phase(ldsg, g, S, E, tid); } break;
                case 2: case 11: { pg8::Gemm g{p.act, p.wb + (k == 2 ? WB_DN0 : WB_DN1), MT, DM, DFF}; S.init(MLAT, DM, DFF, gridDim.x, bid, (k == 11 && last) ? 0 : 4); EpiResid E{p.out, p.xc, mods_l, k == 2 ? 2 : 8, 0.5f, p.part, (l == 0 && k == 2) ? p.x : p.out}; pg8::gemm_phase<EpiResid, false, true>(ldsg, g, S, E, tid); } break;
                case 3: phase_norm(p, l, 1, tid, bid, 4, mods_l + 4 * 9216 + 2 * 1024, 0.5f, p.out, l == 0 ? p.ctx : p.xc); break;
                case 4: { pg8::Gemm g{p.h, p.wb + WB_WIN, MT, DIN, DM}; S.init(MT, DIN, DM, gridDim.x, bid, 0); EpiWin E{p.pa, p.pr}; pg8::gemm_phase(ldsg, g, S, E, tid); } break;
                case 5: phase_prep(p, l, ldsf, tid, bid); break;
                case 6: phase_attn(p, l, ldsf, !last, tid, bid); phase_scan(p, l, ldsf, tid, bid); break;
                case 7: phase_readout(p, l, tid, bid); break;
                case 8: { pg8::Gemm g{p.h, p.wb + WB_WOUT, MT, DM, DM}; S.init(MLAT, DM, DM, gridDim.x, bid, last ? 0 : 2); EpiResid E{p.out, p.xc, mods_l, 5, 1.0f, p.part, p.out}; pg8::gemm_phase<EpiResid, false, true>(ldsg, g, S, E, tid); } break;
                case 9: phase_norm(p, l, 2, tid, bid, last ? 0 : 2, mods_l + 4 * 9216 + 5 * 1024, 1.0f, p.out, p.xc); break;
            }
        }
        if (ph + 1 < p.hi) { if (p.hi < 0) grid.sync(); xcd_barrier(xb, tid); }
    }
}

extern "C" void kernel_launch(void* const* d_in, const int* in_sizes, int n_in, void* d_out, int out_size, void* d_ws, size_t ws_size, hipStream_t stream) {
    static int grid_blocks = 0;
    if (!grid_blocks) {
        int dev = 0, cus = 0, per_cu = 0;
        hipGetDevice(&dev);
        hipDeviceGetAttribute(&cus, hipDeviceAttributeMultiprocessorCount, dev);
        hipFuncSetAttribute((const void*)mega, hipFuncAttributeMaxDynamicSharedMemorySize, LDS_BYTES);
        hipOccupancyMaxActiveBlocksPerMultiprocessor(&per_cu, mega, NTH, LDS_BYTES);
        grid_blocks = cus * per_cu;
        if (grid_blocks > 256) grid_blocks = 256;
        if (grid_blocks < 1) grid_blocks = 1;
    }
    Params p{};
    const float** pp = (const float**)&p;
    for (int i = 0; i < 25; ++i) pp[i] = (const float*)d_in[i];
    p.out = (float*)d_out;
    char* ws = (char*)d_ws; size_t off = 0;
    auto take = [&](size_t bytes) { char* r = ws + off; off += (bytes + 255) & ~(size_t)255; return r; };
    p.wb = (bf16_t*)take(WB_ELEMS * 2);
    p.xc = (float*)take((size_t)MCTX * DM * 4);
    p.mods = (float*)take((size_t)NLAYER * 5 * 9216 * 4);
    p.h = (bf16_t*)take((size_t)MT * DM * 2);
    p.pa = (bf16_t*)take((size_t)MT * 1536 * 2);
    p.pr = (float*)take((size_t)MT * 1792 * 4);
    p.act = p.pa;
    p.o = p.pr;
    p.vT = (bf16_t*)take((size_t)512 * MT * 2);
    p.shh = (bf16_t*)take((size_t)MT * 8 * 192 * 2);
    p.dw = (float*)take((size_t)2 * MT * 8 * 64 * 4);
    p.dkb = (bf16_t*)take((size_t)2 * MT * 8 * 128 * 2);
    p.g = (float*)take((size_t)MT * 512 * 4);
    p.bon = (float*)take((size_t)MT * 8 * 4);
    p.part = (float*)take((size_t)4 * MCTX * DM * 4);
    p.lw = (bf16_t*)take((size_t)196608 * 2);
    p.bar = (unsigned*)take((size_t)XCD_BAR_WORDS * 4);
    (void)hipMemsetAsync(p.bar, 0, (size_t)XCD_BAR_WORDS * 4, stream);
    p.lo = 0; p.hi = 1 + 12 * NLAYER;
    void* args[] = {&p};
    hipError_t e = hipLaunchCooperativeKernel((const void*)mega, dim3(grid_blocks), dim3(NTH), args, LDS_BYTES, stream);
    if (e != hipSuccess) fprintf(stderr, "cooperative launch failed: %s (grid %d)\n", hipGetErrorString(e), grid_blocks);
}
```
